# Optimizing an MI355X kernel written in HIP

```python
import jax, jax.numpy as jnp
from jax import lax
import numpy as np

D_MODEL = 2048
BATCH = 8
SEQ = 2048
DEPTH = 1
DEC_BATCH = 16
DEC_SEQ = 16
PAST_LEN = 2048

CHUNK = 64
N_HEADS = 16
HEAD_DIM = 64
ATTN_W = N_HEADS * HEAD_DIM
POOL_WINDOWS = (2, 4, 8, 16)
POOL_GROUPS = 4
POOL_W = 1024
POOL_GW = POOL_W // POOL_GROUPS
POOL_OUT_GW = D_MODEL // POOL_GROUPS
POOL_HIST = 15
D_FF = 4 * D_MODEL
Q_BLOCK = 128
EPS = 1e-6
SCALE = HEAD_DIM ** -0.5
OFF_Q = 0
OFF_K = OFF_Q + ATTN_W
OFF_V = OFF_K + ATTN_W
OFF_F = OFF_V + ATTN_W
OFF_U = OFF_F + N_HEADS
OFF_GA = OFF_U + POOL_W
OFF_GB = OFF_GA + D_MODEL
IN_W = OFF_GB + D_MODEL

kernel_name = "fox_pool_gated_streaming_encoder"


def rmsnorm(x, g):
    xf = x.astype(jnp.float32)
    y = xf * lax.rsqrt(jnp.mean(xf * xf, axis=-1, keepdims=True) + EPS)
    return (y * g.astype(jnp.float32)).astype(x.dtype)


def split_projection(h, w_in, b_f):
    B, T, _ = h.shape
    p = h @ w_in
    q = p[..., OFF_Q:OFF_K].reshape(B, T, N_HEADS, HEAD_DIM)
    k = p[..., OFF_K:OFF_V].reshape(B, T, N_HEADS, HEAD_DIM)
    v = p[..., OFF_V:OFF_F].reshape(B, T, N_HEADS, HEAD_DIM)
    logf = jax.nn.log_sigmoid(p[..., OFF_F:OFF_U].astype(jnp.float32) + b_f.astype(jnp.float32))
    u = p[..., OFF_U:OFF_GA]
    ga = p[..., OFF_GA:OFF_GB]
    gb = p[..., OFF_GB:IN_W]
    return q, k, v, logf, u, ga, gb


def forgetting_attend(q, k, v, cq, ck, qpos, kpos):
    s = jnp.einsum('bqhd,bkhd->bhqk', q, k).astype(jnp.float32) * SCALE
    bias = jnp.transpose(cq, (0, 2, 1))[..., :, None] - jnp.transpose(ck, (0, 2, 1))[..., None, :]
    mask = kpos[None, :] <= qpos[:, None]
    s = jnp.where(mask, s + bias, -jnp.inf)
    p = jax.nn.softmax(s, axis=-1)
    return jnp.einsum('bhqk,bkhd->bqhd', p.astype(v.dtype), v)


def fox_prompt(q, k, v, logf):
    B, T, H, dh = q.shape
    nb = T // Q_BLOCK
    c = jnp.cumsum(logf, axis=1)
    qb = jnp.transpose(q.reshape(B, nb, Q_BLOCK, H, dh), (1, 0, 2, 3, 4))
    cqb = jnp.transpose(c.reshape(B, nb, Q_BLOCK, H), (1, 0, 2, 3))
    posb = jnp.arange(T).reshape(nb, Q_BLOCK)
    kpos = jnp.arange(T)
    o = lax.map(lambda a: forgetting_attend(a[0], k, v, a[1], c, a[2], kpos), (qb, cqb, posb))
    return jnp.transpose(o, (1, 0, 2, 3, 4)).reshape(B, T, H * dh)


def fox_sample(q, k_all, v_all, logf_all, past):
    B, n, H, dh = q.shape
    c = jnp.cumsum(logf_all.astype(jnp.float32), axis=1)
    qpos = past + jnp.arange(n)
    kpos = jnp.arange(past + n)
    o = forgetting_attend(q, k_all, v_all, c[:, past:], c, qpos, kpos)
    return o.reshape(B, n, H * dh)


def multi_scale_pool(u_hist, u, pos):
    B, n, P = u.shape
    L = POOL_HIST
    ext = jnp.concatenate([u_hist.astype(u.dtype), u], axis=1).astype(jnp.float32)
    cs = jnp.concatenate([jnp.zeros((B, 1, P), jnp.float32), jnp.cumsum(ext, axis=1)], axis=1)
    outs = []
    for g, w in enumerate(POOL_WINDOWS):
        csg = cs[..., g * POOL_GW:(g + 1) * POOL_GW]
        tot = csg[:, L + 1:L + 1 + n] - csg[:, L + 1 - w:L + 1 - w + n]
        cnt = jnp.minimum(pos + 1, w).astype(jnp.float32)[None, :, None]
        outs.append(tot / cnt)
    pooled = jnp.concatenate(outs, axis=-1) - u.astype(jnp.float32)
    return pooled.astype(u.dtype), ext[:, -POOL_HIST:].astype(u.dtype)


def merge_and_ffn(x, a_out, pooled, ga, gb, w_attn_up, w_pool, pool_scale, w_out,
                  g_mix_post, g_ffn_pre, w_ff1, w_ff2, g_ffn_post):
    B, T, _ = x.shape
    br_a = a_out @ w_attn_up
    br_b = jnp.einsum('btgc,gcd->btgd', pooled.reshape(B, T, POOL_GROUPS, POOL_GW),
                      w_pool).reshape(B, T, D_MODEL) * pool_scale
    m = jax.nn.sigmoid(ga) * br_a + jax.nn.sigmoid(gb) * br_b
    x = x + rmsnorm(m @ w_out, g_mix_post)
    h = rmsnorm(x, g_ffn_pre)
    z = jnp.square(jax.nn.relu(h @ w_ff1))
    return x + rmsnorm(z @ w_ff2, g_ffn_post)


def setup_inputs(seed: int = 0) -> dict:
    key = jax.random.key(seed)
    ks = jax.random.split(key, 24)
    f32 = jnp.float32
    nrm = lambda k, s, sc: jax.random.normal(k, s, f32) * sc
    gain = lambda k: 1.0 + 0.1 * jax.random.normal(k, (DEPTH, D_MODEL), f32)
    return {
        "x_prompt": nrm(ks[0], (BATCH, SEQ, D_MODEL), 1.0),
        "x_sample": nrm(ks[1], (DEC_BATCH, DEC_SEQ, D_MODEL), 1.0),
        "cache_k": nrm(ks[2], (DEPTH, DEC_BATCH, PAST_LEN, N_HEADS, HEAD_DIM), 1.0),
        "cache_v": nrm(ks[3], (DEPTH, DEC_BATCH, PAST_LEN, N_HEADS, HEAD_DIM), 1.0),
        "cache_logf": jax.nn.log_sigmoid(3.0 + nrm(ks[4], (DEPTH, DEC_BATCH, PAST_LEN, N_HEADS), 1.0)),
        "state_pool": nrm(ks[5], (DEPTH, DEC_BATCH, POOL_HIST, POOL_W), 1.0),
        "g_mix_pre": gain(ks[6]),
        "w_in": nrm(ks[7], (DEPTH, D_MODEL, IN_W), D_MODEL ** -0.5),
        "b_f": 3.0 + nrm(ks[8], (DEPTH, N_HEADS), 0.1),
        "w_attn_up": nrm(ks[9], (DEPTH, ATTN_W, D_MODEL), ATTN_W ** -0.5),
        "w_pool": nrm(ks[10], (DEPTH, POOL_GROUPS, POOL_GW, POOL_OUT_GW), POOL_GW ** -0.5),
        "pool_scale": gain(ks[11]),
        "w_out": nrm(ks[12], (DEPTH, D_MODEL, D_MODEL), D_MODEL ** -0.5),
        "g_mix_post": gain(ks[13]),
        "g_ffn_pre": gain(ks[14]),
        "w_ff1": nrm(ks[15], (DEPTH, D_MODEL, D_FF), D_MODEL ** -0.5),
        "w_ff2": nrm(ks[16], (DEPTH, D_FF, D_MODEL), D_FF ** -0.5),
        "g_ffn_post": gain(ks[17]),
    }


def reference(x_prompt, x_sample, cache_k, cache_v, cache_logf, state_pool,
              g_mix_pre, w_in, b_f, w_attn_up, w_pool, pool_scale, w_out,
              g_mix_post, g_ffn_pre, w_ff1, w_ff2, g_ffn_post):
    xp, xs = x_prompt, x_sample
    Bp, Tp, _ = xp.shape
    Bs, Ts, _ = xs.shape
    kp_l, vp_l, fp_l, pp_l, ks_l, vs_l, fs_l, ps_l = [], [], [], [], [], [], [], []
    for l in range(DEPTH):
        h = rmsnorm(xp, g_mix_pre[l])
        q, k, v, logf, u, ga, gb = split_projection(h, w_in[l], b_f[l])
        a_out = fox_prompt(q, k, v, logf)
        pooled, pool_new = multi_scale_pool(jnp.zeros((Bp, POOL_HIST, POOL_W), u.dtype), u,
                                            jnp.arange(Tp))
        xp = merge_and_ffn(xp, a_out, pooled, ga, gb, w_attn_up[l], w_pool[l], pool_scale[l],
                           w_out[l], g_mix_post[l], g_ffn_pre[l], w_ff1[l], w_ff2[l], g_ffn_post[l])
        kp_l.append(k); vp_l.append(v); fp_l.append(logf); pp_l.append(pool_new)

        past = cache_k.shape[2]
        h = rmsnorm(xs, g_mix_pre[l])
        q, k, v, logf, u, ga, gb = split_projection(h, w_in[l], b_f[l])
        k_all = jnp.concatenate([cache_k[l].astype(k.dtype), k], axis=1)
        v_all = jnp.concatenate([cache_v[l].astype(v.dtype), v], axis=1)
        f_all = jnp.concatenate([cache_logf[l].astype(jnp.float32), logf], axis=1)
        a_out = fox_sample(q, k_all, v_all, f_all, past)
        pooled, pool_new = multi_scale_pool(state_pool[l], u, past + jnp.arange(Ts))
        xs = merge_and_ffn(xs, a_out, pooled, ga, gb, w_attn_up[l], w_pool[l], pool_scale[l],
                           w_out[l], g_mix_post[l], g_ffn_pre[l], w_ff1[l], w_ff2[l], g_ffn_post[l])
        ks_l.append(k); vs_l.append(v); fs_l.append(logf); ps_l.append(pool_new)

    k_prompt = jnp.stack(kp_l, 0)
    v_prompt = jnp.stack(vp_l, 0)
    logf_prompt = jnp.stack(fp_l, 0)
    pool_prompt = jnp.stack(pp_l, 0)
    k_sample = jnp.stack(ks_l, 0)
    v_sample = jnp.stack(vs_l, 0)
    logf_sample = jnp.stack(fs_l, 0)
    pool_sample = jnp.stack(ps_l, 0)
    return (xp, xs, k_prompt, v_prompt, logf_prompt, pool_prompt,
            k_sample, v_sample, logf_sample, pool_sample)
```

```cpp
#include <hip/hip_runtime.h>
#include <stdint.h>
#include <stdio.h>

typedef unsigned short bf16_t;
typedef short bf16x8 __attribute__((ext_vector_type(8)));
typedef float f32x4 __attribute__((ext_vector_type(4)));
typedef float f32x2 __attribute__((ext_vector_type(2)));
typedef unsigned u32x4 __attribute__((ext_vector_type(4)));
typedef unsigned u32x2 __attribute__((ext_vector_type(2)));

constexpr int D = 2048, BATCH = 8, SEQ = 2048, MP = BATCH * SEQ;
constexpr int SB_ = 16, SN = 16, MS = SB_ * SN;
constexpr int R = MP + MS;
constexpr int PAST = 2048, NH = 16, DH = 64, AW = 1024, PW = 1024, FF = 8192;
constexpr int NKEY = PAST + SN;
constexpr int NMAIN = 8192;
constexpr int C_Q = 0, C_K = 1024, C_V = 2048, C_U = 3072, C_GA = 4096, C_GB = 6144;
constexpr float EPS = 1e-6f, LOG2E = 1.4426950408889634f, QSCALE = 0.125f * LOG2E;

constexpr size_t O_Y = 0;
constexpr size_t O_KP = (size_t)R * D;
constexpr size_t O_VP = O_KP + (size_t)MP * AW;
constexpr size_t O_LP = O_VP + (size_t)MP * AW;
constexpr size_t O_PP = O_LP + (size_t)MP * NH;
constexpr size_t O_KS = O_PP + (size_t)BATCH * 15 * PW;
constexpr size_t O_VS = O_KS + (size_t)MS * AW;
constexpr size_t O_LS = O_VS + (size_t)MS * AW;
constexpr size_t O_PS = O_LS + (size_t)MS * NH;
constexpr size_t O_END = O_PS + (size_t)SB_ * 15 * PW;

constexpr size_t MiB = 1u << 20;
constexpr size_t WS_WIN = 0, WS_WUP = 33 * MiB, WS_WPOOL = 37 * MiB, WS_WOUT = 38 * MiB, WS_WFF1 = 46 * MiB, WS_WFF2 = 78 * MiB;
constexpr size_t WS_H = 110 * MiB;
constexpr size_t WS_TM = 175 * MiB;
constexpr size_t WS_X = 240 * MiB;
constexpr size_t WS_Q = WS_X, WS_K = WS_Q + (size_t)R * AW * 2, WS_V = WS_K + (size_t)R * AW * 2, WS_U = WS_V + (size_t)R * AW * 2,
                 WS_PO = WS_U + (size_t)R * PW * 2, WS_SA = WS_PO + (size_t)R * PW * 2, WS_SB = WS_SA + (size_t)R * D * 2, WS_XEND = WS_SB + (size_t)R * D * 2;
constexpr size_t WS_Z = WS_X;
constexpr size_t WS_MO = WS_X;
constexpr size_t WS_FO = WS_H;
constexpr size_t WS_LOGF = 533 * MiB;
constexpr size_t WS_CP = 535 * MiB;
constexpr size_t WS_CS = 536 * MiB;
constexpr size_t WS_END = 540 * MiB;
static_assert(WS_XEND <= WS_LOGF && WS_Z + (size_t)R * FF * 2 <= WS_LOGF, "ws map");

struct Params {
    const float *xp, *xs, *ck, *cv, *clf, *sp, *g_pre, *w_in, *b_f, *w_up, *w_pool, *pscale, *w_out, *g_post, *g_ffn_pre, *w_ff1, *w_ff2, *g_ffn_post;
    float* out; unsigned char* ws;
};

__device__ __forceinline__ unsigned f2bf(float f) { unsigned u = __builtin_bit_cast(unsigned, f); return (u + 0x7fffu + ((u >> 16) & 1u)) >> 16; }
__device__ __forceinline__ unsigned pk2(float lo, float hi) { return f2bf(lo) | (f2bf(hi) << 16); }
__device__ __forceinline__ float bf2f(unsigned short b) { return __builtin_bit_cast(float, (unsigned)b << 16); }
__device__ __forceinline__ float bflo(unsigned w) { return __builtin_bit_cast(float, w << 16); }
__device__ __forceinline__ float bfhi(unsigned w) { return __builtin_bit_cast(float, w & 0xffff0000u); }
__device__ __forceinline__ float wave_sum(float v) {
#pragma unroll
    for (int o = 1; o < 64; o <<= 1) v += __shfl_xor(v, o);
    return v;
}
__device__ __forceinline__ float sigmoidf_(float x) { return 1.0f / (1.0f + __expf(-x)); }
__device__ __forceinline__ const float* xrow(const Params& p, int row) { return row < MP ? p.xp + (size_t)row * D : p.xs + (size_t)(row - MP) * D; }

__device__ __forceinline__ void tr_item(const float* src, int ld, int col0, int k0, bf16_t* dst, int pitch, int row0, int nvalid, float* scr, int lane) {
#pragma unroll 8
    for (int i = 0; i < 32; ++i) { const int kk = 2 * i + (lane >> 5), n = lane & 31; scr[kk * 33 + n] = (n < nvalid) ? src[(size_t)(k0 + kk) * ld + col0 + n] : 0.f; }
    __builtin_amdgcn_s_waitcnt(0); __builtin_amdgcn_wave_barrier();
    const int c = lane & 7;
#pragma unroll
    for (int j = 0; j < 4; ++j) { const int n = (lane >> 3) + 8 * j; const float* s = scr + (8 * c) * 33 + n;
        u32x4 o; o.x = pk2(s[0 * 33], s[1 * 33]); o.y = pk2(s[2 * 33], s[3 * 33]); o.z = pk2(s[4 * 33], s[5 * 33]); o.w = pk2(s[6 * 33], s[7 * 33]);
        if (n < nvalid) *(u32x4*)(dst + (size_t)(row0 + n) * pitch + k0 + 8 * c) = o; }
    __builtin_amdgcn_s_waitcnt(0); __builtin_amdgcn_wave_barrier();
}
__device__ __forceinline__ void convert_weights(const Params& p, float* scr, int gw, int NGW, int lane) {
    bf16_t* Win = (bf16_t*)(p.ws + WS_WIN); bf16_t* Wup = (bf16_t*)(p.ws + WS_WUP); bf16_t* Wpool = (bf16_t*)(p.ws + WS_WPOOL);
    bf16_t* Wout = (bf16_t*)(p.ws + WS_WOUT); bf16_t* Wff1 = (bf16_t*)(p.ws + WS_WFF1); bf16_t* Wff2 = (bf16_t*)(p.ws + WS_WFF2);
    constexpr int NB_IN = 257;
    constexpr int I_IN = (D / 64) * NB_IN, I_UP = (AW / 64) * (D / 32), I_POOL = 4 * (256 / 64) * (512 / 32), I_OUT = (D / 64) * (D / 32), I_FF1 = (D / 64) * (FF / 32), I_FF2 = (FF / 64) * (D / 32);
    constexpr int NITEMS = I_IN + I_UP + I_POOL + I_OUT + I_FF1 + I_FF2;
    for (int it = gw; it < NITEMS; it += NGW) {
        int r = it;
        if (r < I_IN) { const int kb = r / NB_IN, nb = r % NB_IN, r0 = nb * 32;
            const int c0 = r0 < 3072 ? r0 : (r0 < NMAIN ? r0 + 16 : 3072 + (r0 - NMAIN));
            tr_item(p.w_in, 8208, c0, kb * 64, Win, D, r0, r0 < NMAIN ? 32 : 16, scr, lane); continue; }
        r -= I_IN;
        if (r < I_UP) { const int nblk = D / 32; tr_item(p.w_up, D, (r % nblk) * 32, (r / nblk) * 64, Wup, AW, (r % nblk) * 32, 32, scr, lane); continue; }
        r -= I_UP;
        if (r < I_POOL) { const int g = r / 64, q = r % 64, kb = q / 16, nb = q % 16;
            tr_item(p.w_pool + (size_t)g * 256 * 512, 512, nb * 32, kb * 64, Wpool, 256, g * 512 + nb * 32, 32, scr, lane); continue; }
        r -= I_POOL;
        if (r < I_OUT) { const int nblk = D / 32; tr_item(p.w_out, D, (r % nblk) * 32, (r / nblk) * 64, Wout, D, (r % nblk) * 32, 32, scr, lane); continue; }
        r -= I_OUT;
        if (r < I_FF1) { const int nblk = FF / 32; tr_item(p.w_ff1, FF, (r % nblk) * 32, (r / nblk) * 64, Wff1, D, (r % nblk) * 32, 32, scr, lane); continue; }
        r -= I_FF1;
        { const int nblk = D / 32; tr_item(p.w_ff2, D, (r % nblk) * 32, (r / nblk) * 64, Wff2, FF, (r % nblk) * 32, 32, scr, lane); }
    }
}
__global__ void __launch_bounds__(256) k_convert(Params p) {
    __shared__ float scr_all[4 * 64 * 33];
    const int lane = threadIdx.x & 63, wave = threadIdx.x >> 6;
    convert_weights(p, scr_all + wave * 64 * 33, blockIdx.x * 4 + wave, gridDim.x * 4, lane);
}

__device__ __forceinline__ void rms_row_to_bf16(const float* xr_, const float* g, bf16_t* orow, int lane) {
    const f32x4* xr = (const f32x4*)xr_ + lane; const f32x4* gr = (const f32x4*)g + lane;
    f32x4 v[8]; float s = 0.f;
#pragma unroll
    for (int j = 0; j < 8; ++j) { v[j] = xr[64 * j]; s += (v[j].x * v[j].x + v[j].y * v[j].y) + (v[j].z * v[j].z + v[j].w * v[j].w); }
    const float rstd = rsqrtf(wave_sum(s) * (1.f / D) + EPS);
    u32x2* o8 = (u32x2*)orow + lane;
#pragma unroll
    for (int j = 0; j < 8; ++j) { const f32x4 gg = gr[64 * j]; u32x2 w; w.x = pk2(v[j].x * rstd * gg.x, v[j].y * rstd * gg.y); w.y = pk2(v[j].z * rstd * gg.z, v[j].w * rstd * gg.w); o8[64 * j] = w; }
}
__global__ void __launch_bounds__(512) k_rms_in(Params p) {
    const int lane = threadIdx.x & 63, gw = blockIdx.x * 8 + (threadIdx.x >> 6), NGW = gridDim.x * 8;
    bf16_t* H = (bf16_t*)(p.ws + WS_H);
    for (int row = gw; row < R; row += NGW) rms_row_to_bf16(xrow(p, row), p.g_pre, H + (size_t)row * D, lane);
}

template <int WM, int WN, int TM, int TN, class Epi>
__device__ __forceinline__ void sgemm_tile(unsigned char* smem, const bf16_t* __restrict__ A, int lda, const bf16_t* __restrict__ Bt, int ldb, int K, int row0, int col0, const Epi& E) {
    static_assert(WM * WN == 8, "8 waves");
    constexpr int BM = WM * TM * 16, BN = WN * TN * 16, CA = BM * 8, CB = BN * 8, NA = (CA + 511) / 512, NB = (CB + 511) / 512;
    const int tid = threadIdx.x, lane = tid & 63, wid = tid >> 6, wr = wid / WN, wc = wid % WN, fr = lane & 15, fq = lane >> 4;
    unsigned char* sA = smem; unsigned char* sB = smem + BM * 128;
    f32x4 acc[TM][TN];
#pragma unroll
    for (int m = 0; m < TM; ++m)
#pragma unroll
        for (int n = 0; n < TN; ++n) acc[m][n] = (f32x4){0.f, 0.f, 0.f, 0.f};
    u32x4 ra[NA], rb[NB];
    const int nk = K / 64;
#define SG_GLOAD(kt) do { \
    _Pragma("unroll") for (int i = 0; i < NA; ++i) { const int c = tid + i * 512; if (c < CA) ra[i] = *(const u32x4*)(A + (size_t)(row0 + (c >> 3)) * lda + (kt) * 64 + (c & 7) * 8); } \
    _Pragma("unroll") for (int i = 0; i < NB; ++i) { const int c = tid + i * 512; if (c < CB) rb[i] = *(const u32x4*)(Bt + (size_t)(col0 + (c >> 3)) * ldb + (kt) * 64 + (c & 7) * 8); } } while (0)
    SG_GLOAD(0);
    for (int kt = 0; kt < nk; ++kt) {
        __syncthreads();
#pragma unroll
        for (int i = 0; i < NA; ++i) { const int c = tid + i * 512; if (c < CA) { const int r = c >> 3, ch = c & 7; *(u32x4*)(sA + r * 128 + ((ch ^ (r & 7)) << 4)) = ra[i]; } }
#pragma unroll
        for (int i = 0; i < NB; ++i) { const int c = tid + i * 512; if (c < CB) { const int r = c >> 3, ch = c & 7; *(u32x4*)(sB + r * 128 + ((ch ^ (r & 7)) << 4)) = rb[i]; } }
        __syncthreads();
        if (kt + 1 < nk) SG_GLOAD(kt + 1);
#pragma unroll
        for (int kk = 0; kk < 2; ++kk) {
            bf16x8 af[TM], bfr[TN];
#pragma unroll
            for (int m = 0; m < TM; ++m) { const int r = (wr * TM + m) * 16 + fr, ch = kk * 4 + fq; af[m] = *(const bf16x8*)(sA + r * 128 + ((ch ^ (r & 7)) << 4)); }
#pragma unroll
            for (int n = 0; n < TN; ++n) { const int r = (wc * TN + n) * 16 + fr, ch = kk * 4 + fq; bfr[n] = *(const bf16x8*)(sB + r * 128 + ((ch ^ (r & 7)) << 4)); }
#pragma unroll
            for (int m = 0; m < TM; ++m)
#pragma unroll
                for (int n = 0; n < TN; ++n) acc[m][n] = __builtin_amdgcn_mfma_f32_16x16x32_bf16(bfr[n], af[m], acc[m][n], 0, 0, 0);
        }
    }
#undef SG_GLOAD
#pragma unroll
    for (int m = 0; m < TM; ++m)
#pragma unroll
        for (int n = 0; n < TN; ++n) E(row0 + (wr * TM + m) * 16 + fr, col0 + (wc * TN + n) * 16 + 4 * fq, acc[m][n]);
}

__device__ __forceinline__ void st_bf16x4(bf16_t* p, f32x4 v) { u32x2 w; w.x = pk2(v.x, v.y); w.y = pk2(v.z, v.w); *(u32x2*)p = w; }
__device__ __forceinline__ f32x4 ld_bf16x4(const bf16_t* p) { const u32x2 w = *(const u32x2*)p; return (f32x4){bflo(w.x), bfhi(w.x), bflo(w.y), bfhi(w.y)}; }

struct EpiIn {
    bf16_t *Q, *Kb, *Vb, *U, *SA, *SB; float* out; const float* pscale;
    __device__ __forceinline__ void operator()(int row, int col, f32x4 v) const {
        if (col < C_K) { st_bf16x4(Q + (size_t)row * AW + col, v * QSCALE); }
        else if (col < C_U) {
            const bool isk = col < C_V; const int c = col - (isk ? C_K : C_V);
            st_bf16x4((isk ? Kb : Vb) + (size_t)row * AW + c, v);
            float* o = row < MP ? out + (isk ? O_KP : O_VP) + (size_t)row * AW + c : out + (isk ? O_KS : O_VS) + (size_t)(row - MP) * AW + c;
            *(f32x4*)o = v;
        } else if (col < C_GA) {
            const int c = col - C_U; st_bf16x4(U + (size_t)row * PW + c, v);
            if (row < MP) { const int b = row / SEQ, t = row % SEQ; if (t >= SEQ - 15) *(f32x4*)(out + O_PP + ((size_t)b * 15 + (t - (SEQ - 15))) * PW + c) = v; }
            else { const int rs = row - MP, b = rs / SN, i = rs % SN; if (i >= 1) *(f32x4*)(out + O_PS + ((size_t)b * 15 + (i - 1)) * PW + c) = v; }
        } else if (col < C_GB) { const int c = col - C_GA; f32x4 s = {sigmoidf_(v.x), sigmoidf_(v.y), sigmoidf_(v.z), sigmoidf_(v.w)}; st_bf16x4(SA + (size_t)row * D + c, s); }
        else { const int c = col - C_GB; const f32x4 ps = *(const f32x4*)(pscale + c); f32x4 s = {sigmoidf_(v.x) * ps.x, sigmoidf_(v.y) * ps.y, sigmoidf_(v.z) * ps.z, sigmoidf_(v.w) * ps.w}; st_bf16x4(SB + (size_t)row * D + c, s); }
    }
};
__global__ void __launch_bounds__(512) k_gemm_in(Params p) {
    __shared__ __attribute__((aligned(16))) unsigned char smem[32768];
    const int tm = blockIdx.x % (R / 128), tn = blockIdx.x / (R / 128);
    EpiIn E{(bf16_t*)(p.ws + WS_Q), (bf16_t*)(p.ws + WS_K), (bf16_t*)(p.ws + WS_V), (bf16_t*)(p.ws + WS_U), (bf16_t*)(p.ws + WS_SA), (bf16_t*)(p.ws + WS_SB), p.out, p.pscale};
    sgemm_tile<2, 4, 4, 2>(smem, (const bf16_t*)(p.ws + WS_H), D, (const bf16_t*)(p.ws + WS_WIN), D, D, tm * 128, tn * 128, E);
}
struct EpiLogf {
    float* LOGF; float* out; const float* b_f;
    __device__ __forceinline__ void operator()(int row, int col, f32x4 v) const {
        const f32x4 b = *(const f32x4*)(b_f + col); f32x4 r;
#pragma unroll
        for (int e = 0; e < 4; ++e) { const float z = v[e] + b[e]; r[e] = fminf(z, 0.f) - log1pf(__expf(-fabsf(z))); }
        *(f32x4*)(LOGF + (size_t)row * NH + col) = r;
        float* o = row < MP ? out + O_LP + (size_t)row * NH + col : out + O_LS + (size_t)(row - MP) * NH + col;
        *(f32x4*)o = r;
    }
};
__global__ void __launch_bounds__(512) k_gemm_logf(Params p) {
    __shared__ __attribute__((aligned(16))) unsigned char smem[(128 + 16) * 128];
    EpiLogf E{(float*)(p.ws + WS_LOGF), p.out, p.b_f};
    sgemm_tile<8, 1, 1, 1>(smem, (const bf16_t*)(p.ws + WS_H), D, (const bf16_t*)(p.ws + WS_WIN) + (size_t)NMAIN * D, D, D, blockIdx.x * 128, 0, E);
}

__device__ __forceinline__ float wave_incl_scan(float v, int lane) {
#pragma unroll
    for (int o = 1; o < 64; o <<= 1) { const float t = __shfl_up(v, o); if (lane >= o) v += t; }
    return v;
}
__global__ void __launch_bounds__(64) k_cumsum(Params p) {
    const int lane = threadIdx.x, id = blockIdx.x; const float* LOGF = (const float*)(p.ws + WS_LOGF);
    if (id < BATCH * NH) { const int b = id / NH, h = id % NH; float* C = (float*)(p.ws + WS_CP) + (size_t)id * SEQ; float carry = 0.f;
        for (int ch = 0; ch < SEQ / 64; ++ch) { const int t = ch * 64 + lane; float v = LOGF[((size_t)b * SEQ + t) * NH + h]; v = wave_incl_scan(v, lane) + carry; C[t] = v * LOG2E; carry = __shfl(v, 63); }
    } else { const int id2 = id - BATCH * NH, b = id2 / NH, h = id2 % NH; float* C = (float*)(p.ws + WS_CS) + (size_t)id2 * NKEY; float carry = 0.f;
        for (int ch = 0; ch < (NKEY + 63) / 64; ++ch) { const int t = ch * 64 + lane; float v = 0.f;
            if (t < PAST) v = p.clf[((size_t)b * PAST + t) * NH + h]; else if (t < NKEY) v = LOGF[((size_t)MP + b * SN + (t - PAST)) * NH + h];
            v = wave_incl_scan(v, lane) + carry; if (t < NKEY) C[t] = v * LOG2E; carry = __shfl(v, 63); }
    }
}

__global__ void __launch_bounds__(64) k_attn_prompt(Params p) {
    const int lane = threadIdx.x, tb = blockIdx.x % (SEQ / 64), bh = blockIdx.x / (SEQ / 64), b = bh / NH, h = bh % NH, t = tb * 64 + lane;
    const bf16_t* Q = (const bf16_t*)(p.ws + WS_Q); const bf16_t* Kb = (const bf16_t*)(p.ws + WS_K); const bf16_t* Vb = (const bf16_t*)(p.ws + WS_V);
    const float* C = (const float*)(p.ws + WS_CP) + (size_t)bh * SEQ;
    float q[DH], o[DH];
    { const u32x4* qp = (const u32x4*)(Q + ((size_t)b * SEQ + t) * AW + h * DH);
#pragma unroll
      for (int i = 0; i < 8; ++i) { const u32x4 w = qp[i]; q[8 * i] = bflo(w.x); q[8 * i + 1] = bfhi(w.x); q[8 * i + 2] = bflo(w.y); q[8 * i + 3] = bfhi(w.y); q[8 * i + 4] = bflo(w.z); q[8 * i + 5] = bfhi(w.z); q[8 * i + 6] = bflo(w.w); q[8 * i + 7] = bfhi(w.w); } }
#pragma unroll
    for (int d = 0; d < DH; ++d) o[d] = 0.f;
    const float ct = C[t]; float m = -INFINITY, l = 0.f;
    const int smax = tb * 64 + 63;
    for (int s = 0; s <= smax; ++s) {
        const u32x4* kp = (const u32x4*)(Kb + ((size_t)b * SEQ + s) * AW + h * DH);
        float dot = 0.f;
#pragma unroll
        for (int i = 0; i < 8; ++i) { const u32x4 w = kp[i];
            dot += q[8 * i] * bflo(w.x) + q[8 * i + 1] * bfhi(w.x) + q[8 * i + 2] * bflo(w.y) + q[8 * i + 3] * bfhi(w.y) + q[8 * i + 4] * bflo(w.z) + q[8 * i + 5] * bfhi(w.z) + q[8 * i + 6] * bflo(w.w) + q[8 * i + 7] * bfhi(w.w); }
        const float sc = (s <= t) ? dot + ct - C[s] : -INFINITY;
        const float mn = fmaxf(m, sc), alpha = exp2f(m - mn), pe = exp2f(sc - mn);
        l = l * alpha + pe; m = mn;
        const u32x4* vp = (const u32x4*)(Vb + ((size_t)b * SEQ + s) * AW + h * DH);
#pragma unroll
        for (int i = 0; i < 8; ++i) { const u32x4 w = vp[i];
            o[8 * i] = o[8 * i] * alpha + pe * bflo(w.x); o[8 * i + 1] = o[8 * i + 1] * alpha + pe * bfhi(w.x); o[8 * i + 2] = o[8 * i + 2] * alpha + pe * bflo(w.y); o[8 * i + 3] = o[8 * i + 3] * alpha + pe * bfhi(w.y);
            o[8 * i + 4] = o[8 * i + 4] * alpha + pe * bflo(w.z); o[8 * i + 5] = o[8 * i + 5] * alpha + pe * bfhi(w.z); o[8 * i + 6] = o[8 * i + 6] * alpha + pe * bflo(w.w); o[8 * i + 7] = o[8 * i + 7] * alpha + pe * bfhi(w.w); }
    }
    const float rl = 1.f / l;
    bf16_t* op = (bf16_t*)(p.ws + WS_Q) + ((size_t)b * SEQ + t) * AW + h * DH;
#pragma unroll
    for (int i = 0; i < 8; ++i) { u32x4 w; w.x = pk2(o[8 * i] * rl, o[8 * i + 1] * rl); w.y = pk2(o[8 * i + 2] * rl, o[8 * i + 3] * rl); w.z = pk2(o[8 * i + 4] * rl, o[8 * i + 5] * rl); w.w = pk2(o[8 * i + 6] * rl, o[8 * i + 7] * rl); ((u32x4*)op)[i] = w; }
}
__global__ void __launch_bounds__(64) k_attn_sample(Params p) {
    __shared__ float sm[64 * 67];
    const int lane = threadIdx.x, i = lane & 15, part = lane >> 4, bh = blockIdx.x, b = bh / NH, h = bh % NH;
    const bf16_t* Q = (const bf16_t*)(p.ws + WS_Q); const bf16_t* Kb = (const bf16_t*)(p.ws + WS_K); const bf16_t* Vb = (const bf16_t*)(p.ws + WS_V);
    const float* C = (const float*)(p.ws + WS_CS) + (size_t)bh * NKEY;
    const int qrow = MP + b * SN + i;
    float q[DH], o[DH];
    { const u32x4* qp = (const u32x4*)(Q + (size_t)qrow * AW + h * DH);
#pragma unroll
      for (int e = 0; e < 8; ++e) { const u32x4 w = qp[e]; q[8 * e] = bflo(w.x); q[8 * e + 1] = bfhi(w.x); q[8 * e + 2] = bflo(w.y); q[8 * e + 3] = bfhi(w.y); q[8 * e + 4] = bflo(w.z); q[8 * e + 5] = bfhi(w.z); q[8 * e + 6] = bflo(w.w); q[8 * e + 7] = bfhi(w.w); } }
#pragma unroll
    for (int d = 0; d < DH; ++d) o[d] = 0.f;
    const float ct = C[PAST + i]; float m = -INFINITY, l = 0.f;
    for (int s = part * 516; s < part * 516 + 516; ++s) {
        float kk[DH], vv[DH];
        if (s < PAST) { const f32x4* kp = (const f32x4*)(p.ck + (((size_t)b * PAST + s) * NH + h) * DH); const f32x4* vp = (const f32x4*)(p.cv + (((size_t)b * PAST + s) * NH + h) * DH);
#pragma unroll
            for (int e = 0; e < 16; ++e) { const f32x4 a = kp[e], c = vp[e]; kk[4 * e] = a.x; kk[4 * e + 1] = a.y; kk[4 * e + 2] = a.z; kk[4 * e + 3] = a.w; vv[4 * e] = c.x; vv[4 * e + 1] = c.y; vv[4 * e + 2] = c.z; vv[4 * e + 3] = c.w; }
        } else { const int r2 = MP + b * SN + (s - PAST); const u32x4* kp = (const u32x4*)(Kb + (size_t)r2 * AW + h * DH); const u32x4* vp = (const u32x4*)(Vb + (size_t)r2 * AW + h * DH);
#pragma unroll
            for (int e = 0; e < 8; ++e) { const u32x4 a = kp[e], c = vp[e];
                kk[8 * e] = bflo(a.x); kk[8 * e + 1] = bfhi(a.x); kk[8 * e + 2] = bflo(a.y); kk[8 * e + 3] = bfhi(a.y); kk[8 * e + 4] = bflo(a.z); kk[8 * e + 5] = bfhi(a.z); kk[8 * e + 6] = bflo(a.w); kk[8 * e + 7] = bfhi(a.w);
                vv[8 * e] = bflo(c.x); vv[8 * e + 1] = bfhi(c.x); vv[8 * e + 2] = bflo(c.y); vv[8 * e + 3] = bfhi(c.y); vv[8 * e + 4] = bflo(c.z); vv[8 * e + 5] = bfhi(c.z); vv[8 * e + 6] = bflo(c.w); vv[8 * e + 7] = bfhi(c.w); }
        }
        float dot = 0.f;
#pragma unroll
        for (int d = 0; d < DH; ++d) dot += q[d] * kk[d];
        const bool ok = (s < PAST) || (s - PAST <= i);
        const float sc = ok ? dot + ct - C[s] : -INFINITY;
        const float mn = fmaxf(m, sc), alpha = exp2f(m - mn), pe = exp2f(sc - mn);
        l = l * alpha + pe; m = mn;
#pragma unroll
        for (int d = 0; d < DH; ++d) o[d] = o[d] * alpha + pe * vv[d];
    }
    float* my = sm + lane * 67; my[64] = m; my[65] = l;
#pragma unroll
    for (int d = 0; d < DH; ++d) my[d] = o[d];
    __syncthreads();
    float M = -INFINITY;
#pragma unroll
    for (int pp = 0; pp < 4; ++pp) M = fmaxf(M, sm[(pp * 16 + i) * 67 + 64]);
    float L = 0.f, w[4];
#pragma unroll
    for (int pp = 0; pp < 4; ++pp) { w[pp] = exp2f(sm[(pp * 16 + i) * 67 + 64] - M); L += w[pp] * sm[(pp * 16 + i) * 67 + 65]; }
    const float rl = 1.f / L;
    float r[16];
#pragma unroll
    for (int d = 0; d < 16; ++d) { float a = 0.f;
#pragma unroll
        for (int pp = 0; pp < 4; ++pp) a += w[pp] * sm[(pp * 16 + i) * 67 + part * 16 + d];
        r[d] = a * rl; }
    bf16_t* op = (bf16_t*)(p.ws + WS_Q) + (size_t)qrow * AW + h * DH + part * 16;
    __syncthreads();
    u32x4 w0, w1; w0.x = pk2(r[0], r[1]); w0.y = pk2(r[2], r[3]); w0.z = pk2(r[4], r[5]); w0.w = pk2(r[6], r[7]); w1.x = pk2(r[8], r[9]); w1.y = pk2(r[10], r[11]); w1.z = pk2(r[12], r[13]); w1.w = pk2(r[14], r[15]);
    ((u32x4*)op)[0] = w0; ((u32x4*)op)[1] = w1;
}

__device__ __forceinline__ void pool_chunk(const Params& p, int row, int ch) {
    const bf16_t* U = (const bf16_t*)(p.ws + WS_U); bf16_t* PO = (bf16_t*)(p.ws + WS_PO);
    const int c0 = ch * 8, g = c0 >> 8, w = 2 << g;
    float s[8]; float cur[8];
#pragma unroll
    for (int e = 0; e < 8; ++e) s[e] = 0.f;
    float cnt;
    if (row < MP) { const int t = row % SEQ; const int n = (t + 1 < w) ? t + 1 : w; cnt = (float)n;
        for (int j = 0; j < n; ++j) { const u32x4 v = *(const u32x4*)(U + (size_t)(row - j) * PW + c0);
            const float f[8] = {bflo(v.x), bfhi(v.x), bflo(v.y), bfhi(v.y), bflo(v.z), bfhi(v.z), bflo(v.w), bfhi(v.w)};
#pragma unroll
            for (int e = 0; e < 8; ++e) { s[e] += f[e]; if (j == 0) cur[e] = f[e]; } }
    } else { const int rs = row - MP, b = rs / SN, i = rs % SN; cnt = (float)w;
        for (int j = 0; j < w; ++j) { const int e_ = 15 + i - j;
            float f[8];
            if (e_ >= 15) { const u32x4 v = *(const u32x4*)(U + (size_t)(MP + b * SN + (e_ - 15)) * PW + c0);
                f[0] = bflo(v.x); f[1] = bfhi(v.x); f[2] = bflo(v.y); f[3] = bfhi(v.y); f[4] = bflo(v.z); f[5] = bfhi(v.z); f[6] = bflo(v.w); f[7] = bfhi(v.w); }
            else { const f32x4 a = *(const f32x4*)(p.sp + ((size_t)b * 15 + e_) * PW + c0), c = *(const f32x4*)(p.sp + ((size_t)b * 15 + e_) * PW + c0 + 4);
                f[0] = a.x; f[1] = a.y; f[2] = a.z; f[3] = a.w; f[4] = c.x; f[5] = c.y; f[6] = c.z; f[7] = c.w; }
#pragma unroll
            for (int e = 0; e < 8; ++e) { s[e] += f[e]; if (j == 0) cur[e] = f[e]; } }
    }
    u32x4 o; o.x = pk2(s[0] / cnt - cur[0], s[1] / cnt - cur[1]); o.y = pk2(s[2] / cnt - cur[2], s[3] / cnt - cur[3]); o.z = pk2(s[4] / cnt - cur[4], s[5] / cnt - cur[5]); o.w = pk2(s[6] / cnt - cur[6], s[7] / cnt - cur[7]);
    *(u32x4*)(PO + (size_t)row * PW + c0) = o;
}
__global__ void __launch_bounds__(256) k_pool(Params p) {
    const int n = R * (PW / 8);
    for (int idx = blockIdx.x * 256 + threadIdx.x; idx < n; idx += gridDim.x * 256) pool_chunk(p, idx / (PW / 8), idx % (PW / 8));
}

struct EpiPool { const bf16_t* SB; bf16_t* T;
    __device__ __forceinline__ void operator()(int row, int col, f32x4 v) const { const f32x4 s = ld_bf16x4(SB + (size_t)row * D + col); st_bf16x4(T + (size_t)row * D + col, v * s); } };
struct EpiUp { const bf16_t* SA; bf16_t* T;
    __device__ __forceinline__ void operator()(int row, int col, f32x4 v) const { const f32x4 s = ld_bf16x4(SA + (size_t)row * D + col), t = ld_bf16x4(T + (size_t)row * D + col); st_bf16x4(T + (size_t)row * D + col, v * s + t); } };
__global__ void __launch_bounds__(512) k_gemm_pool(Params p) {
    __shared__ __attribute__((aligned(16))) unsigned char smem[32768];
    const int tm = blockIdx.x % (R / 128), tn = blockIdx.x / (R / 128), g = (tn * 128) / 512;
    EpiPool E{(const bf16_t*)(p.ws + WS_SB), (bf16_t*)(p.ws + WS_TM)};
    sgemm_tile<2, 4, 4, 2>(smem, (const bf16_t*)(p.ws + WS_PO) + g * 256, PW, (const bf16_t*)(p.ws + WS_WPOOL), 256, 256, tm * 128, tn * 128, E);
}
__global__ void __launch_bounds__(512) k_gemm_up(Params p) {
    __shared__ __attribute__((aligned(16))) unsigned char smem[32768];
    const int tm = blockIdx.x % (R / 128), tn = blockIdx.x / (R / 128);
    EpiUp E{(const bf16_t*)(p.ws + WS_SA), (bf16_t*)(p.ws + WS_TM)};
    sgemm_tile<2, 4, 4, 2>(smem, (const bf16_t*)(p.ws + WS_Q), AW, (const bf16_t*)(p.ws + WS_WUP), AW, AW, tm * 128, tn * 128, E);
}
struct EpiF32 { float* C; int ldc;
    __device__ __forceinline__ void operator()(int row, int col, f32x4 v) const { *(f32x4*)(C + (size_t)row * ldc + col) = v; } };
struct EpiRelu2 { bf16_t* Z;
    __device__ __forceinline__ void operator()(int row, int col, f32x4 v) const { f32x4 r;
#pragma unroll
        for (int e = 0; e < 4; ++e) { const float a = fmaxf(v[e], 0.f); r[e] = a * a; }
        st_bf16x4(Z + (size_t)row * FF + col, r); } };
__global__ void __launch_bounds__(512) k_gemm_out(Params p) {
    __shared__ __attribute__((aligned(16))) unsigned char smem[32768];
    const int tm = blockIdx.x % (R / 128), tn = blockIdx.x / (R / 128);
    EpiF32 E{(float*)(p.ws + WS_MO), D};
    sgemm_tile<2, 4, 4, 2>(smem, (const bf16_t*)(p.ws + WS_TM), D, (const bf16_t*)(p.ws + WS_WOUT), D, D, tm * 128, tn * 128, E);
}
__global__ void __launch_bounds__(512) k_gemm_ff1(Params p) {
    __shared__ __attribute__((aligned(16))) unsigned char smem[32768];
    const int tm = blockIdx.x % (R / 128), tn = blockIdx.x / (R / 128);
    EpiRelu2 E{(bf16_t*)(p.ws + WS_Z)};
    sgemm_tile<2, 4, 4, 2>(smem, (const bf16_t*)(p.ws + WS_H), D, (const bf16_t*)(p.ws + WS_WFF1), D, D, tm * 128, tn * 128, E);
}
__global__ void __launch_bounds__(512) k_gemm_ff2(Params p) {
    __shared__ __attribute__((aligned(16))) unsigned char smem[32768];
    const int tm = blockIdx.x % (R / 128), tn = blockIdx.x / (R / 128);
    EpiF32 E{(float*)(p.ws + WS_FO), D};
    sgemm_tile<2, 4, 4, 2>(smem, (const bf16_t*)(p.ws + WS_Z), FF, (const bf16_t*)(p.ws + WS_WFF2), FF, FF, tm * 128, tn * 128, E);
}
__global__ void __launch_bounds__(512) k_norm_mid(Params p) {
    const int lane = threadIdx.x & 63, gw = blockIdx.x * 8 + (threadIdx.x >> 6), NGW = gridDim.x * 8;
    bf16_t* H = (bf16_t*)(p.ws + WS_H); const float* MO = (const float*)(p.ws + WS_MO);
    for (int row = gw; row < R; row += NGW) {
        const f32x4* mr = (const f32x4*)(MO + (size_t)row * D) + lane; const f32x4* xr = (const f32x4*)xrow(p, row) + lane;
        const f32x4* g1 = (const f32x4*)p.g_post + lane; const f32x4* g2 = (const f32x4*)p.g_ffn_pre + lane;
        f32x4 v[8]; float s = 0.f;
#pragma unroll
        for (int j = 0; j < 8; ++j) { v[j] = mr[64 * j]; s += (v[j].x * v[j].x + v[j].y * v[j].y) + (v[j].z * v[j].z + v[j].w * v[j].w); }
        const float r1 = rsqrtf(wave_sum(s) * (1.f / D) + EPS); float s2 = 0.f;
        f32x4* orow = (f32x4*)(p.out + O_Y + (size_t)row * D) + lane;
#pragma unroll
        for (int j = 0; j < 8; ++j) { v[j] = xr[64 * j] + v[j] * r1 * g1[64 * j]; orow[64 * j] = v[j]; s2 += (v[j].x * v[j].x + v[j].y * v[j].y) + (v[j].z * v[j].z + v[j].w * v[j].w); }
        const float r2 = rsqrtf(wave_sum(s2) * (1.f / D) + EPS);
        u32x2* o8 = (u32x2*)(H + (size_t)row * D) + lane;
#pragma unroll
        for (int j = 0; j < 8; ++j) { const f32x4 gg = g2[64 * j]; u32x2 w; w.x = pk2(v[j].x * r2 * gg.x, v[j].y * r2 * gg.y); w.y = pk2(v[j].z * r2 * gg.z, v[j].w * r2 * gg.w); o8[64 * j] = w; }
    }
}
__global__ void __launch_bounds__(512) k_norm_out(Params p) {
    const int lane = threadIdx.x & 63, gw = blockIdx.x * 8 + (threadIdx.x >> 6), NGW = gridDim.x * 8;
    const float* FO = (const float*)(p.ws + WS_FO);
    for (int row = gw; row < R; row += NGW) {
        const f32x4* fr = (const f32x4*)(FO + (size_t)row * D) + lane; const f32x4* g3 = (const f32x4*)p.g_ffn_post + lane;
        f32x4 v[8]; float s = 0.f;
#pragma unroll
        for (int j = 0; j < 8; ++j) { v[j] = fr[64 * j]; s += (v[j].x * v[j].x + v[j].y * v[j].y) + (v[j].z * v[j].z + v[j].w * v[j].w); }
        const float r1 = rsqrtf(wave_sum(s) * (1.f / D) + EPS);
        f32x4* orow = (f32x4*)(p.out + O_Y + (size_t)row * D) + lane;
#pragma unroll
        for (int j = 0; j < 8; ++j) orow[64 * j] = orow[64 * j] + v[j] * r1 * g3[64 * j];
    }
}

extern "C" void kernel_launch(void* const* d_in, const int* in_sizes, int n_in, void* d_out, int out_size, void* d_ws, size_t ws_size, hipStream_t stream) {
    if (n_in != 18 || (size_t)out_size != O_END || ws_size < WS_END) { fprintf(stderr, "kernel_launch: unexpected sizes n_in %d out %d ws %zu\n", n_in, out_size, ws_size); return; }
    Params p{};
    p.xp = (const float*)d_in[0]; p.xs = (const float*)d_in[1]; p.ck = (const float*)d_in[2]; p.cv = (const float*)d_in[3]; p.clf = (const float*)d_in[4]; p.sp = (const float*)d_in[5];
    p.g_pre = (const float*)d_in[6]; p.w_in = (const float*)d_in[7]; p.b_f = (const float*)d_in[8]; p.w_up = (const float*)d_in[9]; p.w_pool = (const float*)d_in[10]; p.pscale = (const float*)d_in[11];
    p.w_out = (const float*)d_in[12]; p.g_post = (const float*)d_in[13]; p.g_ffn_pre = (const float*)d_in[14]; p.w_ff1 = (const float*)d_in[15]; p.w_ff2 = (const float*)d_in[16]; p.g_ffn_post = (const float*)d_in[17];
    p.out = (float*)d_out; p.ws = (unsigned char*)d_ws;
    k_convert<<<2048, 256, 0, stream>>>(p);
    k_rms_in<<<1040, 512, 0, stream>>>(p);
    k_gemm_in<<<(R / 128) * (NMAIN / 128), 512, 0, stream>>>(p);
    k_gemm_logf<<<R / 128, 512, 0, stream>>>(p);
    k_cumsum<<<BATCH * NH + SB_ * NH, 64, 0, stream>>>(p);
    k_pool<<<2048, 256, 0, stream>>>(p);
    k_attn_prompt<<<BATCH * NH * (SEQ / 64), 64, 0, stream>>>(p);
    k_attn_sample<<<SB_ * NH, 64, 0, stream>>>(p);
    k_gemm_pool<<<(R / 128) * (D / 128), 512, 0, stream>>>(p);
    k_gemm_up<<<(R / 128) * (D / 128), 512, 0, stream>>>(p);
    k_gemm_out<<<(R / 128) * (D / 128), 512, 0, stream>>>(p);
    k_norm_mid<<<1040, 512, 0, stream>>>(p);
    k_gemm_ff1<<<(R / 128) * (FF / 128), 512, 0, stream>>>(p);
    k_gemm_ff2<<<(R / 128) * (D / 128), 512, 0, stream>>>(p);
    k_norm_out<<<1040, 512, 0, stream>>>(p);
}
```

```cpp
#include <hip/hip_runtime.h>
#include <stdint.h>
#include <stdio.h>

typedef unsigned short bf16_t;
typedef short bf16x8 __attribute__((ext_vector_type(8)));
typedef float f32x4 __attribute__((ext_vector_type(4)));
typedef float f32x2 __attribute__((ext_vector_type(2)));
typedef unsigned u32x4 __attribute__((ext_vector_type(4)));
typedef unsigned u32x2 __attribute__((ext_vector_type(2)));

constexpr int D = 2048, BATCH = 8, SEQ = 2048, MP = BATCH * SEQ;
constexpr int SB_ = 16, SN = 16, MS = SB_ * SN;
constexpr int R = MP + MS;
constexpr int PAST = 2048, NH = 16, DH = 64, AW = 1024, PW = 1024, FF = 8192;
constexpr int NKEY = PAST + SN;
constexpr int NMAIN = 8192;
constexpr int C_Q = 0, C_K = 1024, C_V = 2048, C_U = 3072, C_GA = 4096, C_GB = 6144;
constexpr float EPS = 1e-6f, LOG2E = 1.4426950408889634f, QSCALE = 0.125f * LOG2E;

constexpr size_t O_Y = 0;
constexpr size_t O_KP = (size_t)R * D;
constexpr size_t O_VP = O_KP + (size_t)MP * AW;
constexpr size_t O_LP = O_VP + (size_t)MP * AW;
constexpr size_t O_PP = O_LP + (size_t)MP * NH;
constexpr size_t O_KS = O_PP + (size_t)BATCH * 15 * PW;
constexpr size_t O_VS = O_KS + (size_t)MS * AW;
constexpr size_t O_LS = O_VS + (size_t)MS * AW;
constexpr size_t O_PS = O_LS + (size_t)MS * NH;
constexpr size_t O_END = O_PS + (size_t)SB_ * 15 * PW;

constexpr size_t MiB = 1u << 20;
constexpr size_t WS_WIN = 0, WS_WUP = 33 * MiB, WS_WPOOL = 37 * MiB, WS_WOUT = 38 * MiB, WS_WFF1 = 46 * MiB, WS_WFF2 = 78 * MiB;
constexpr size_t WS_H = 110 * MiB;
constexpr size_t WS_TM = 175 * MiB;
constexpr size_t WS_X = 240 * MiB;
constexpr size_t WS_Q = WS_X, WS_K = WS_Q + (size_t)R * AW * 2, WS_V = WS_K + (size_t)R * AW * 2, WS_U = WS_V + (size_t)R * AW * 2,
                 WS_PO = WS_U + (size_t)R * PW * 2, WS_SA = WS_PO + (size_t)R * PW * 2, WS_SB = WS_SA + (size_t)R * D * 2, WS_XEND = WS_SB + (size_t)R * D * 2;
constexpr size_t WS_Z = WS_X;
constexpr size_t WS_MO = WS_X;
constexpr size_t WS_FO = WS_H;
constexpr size_t WS_LOGF = 533 * MiB;
constexpr size_t WS_CP = 535 * MiB;
constexpr size_t WS_CS = 536 * MiB;
constexpr size_t WS_CTL = 540 * MiB;
constexpr size_t WS_END = 541 * MiB;
static_assert(WS_XEND <= WS_LOGF && WS_Z + (size_t)R * FF * 2 <= WS_LOGF, "ws map");

struct Params {
    const float *xp, *xs, *ck, *cv, *clf, *sp, *g_pre, *w_in, *b_f, *w_up, *w_pool, *pscale, *w_out, *g_post, *g_ffn_pre, *w_ff1, *w_ff2, *g_ffn_post;
    float* out; unsigned char* ws; int ph_lo, ph_hi;
};

__device__ __forceinline__ unsigned f2bf(float f) { unsigned u = __builtin_bit_cast(unsigned, f); return (u + 0x7fffu + ((u >> 16) & 1u)) >> 16; }
__device__ __forceinline__ unsigned pk2(float lo, float hi) { return f2bf(lo) | (f2bf(hi) << 16); }
__device__ __forceinline__ float bf2f(unsigned short b) { return __builtin_bit_cast(float, (unsigned)b << 16); }
__device__ __forceinline__ float bflo(unsigned w) { return __builtin_bit_cast(float, w << 16); }
__device__ __forceinline__ float bfhi(unsigned w) { return __builtin_bit_cast(float, w & 0xffff0000u); }
__device__ __forceinline__ float wave_sum(float v) {
#pragma unroll
    for (int o = 1; o < 64; o <<= 1) v += __shfl_xor(v, o);
    return v;
}
__device__ __forceinline__ float sigmoidf_(float x) { return 1.0f / (1.0f + __expf(-x)); }
__device__ __forceinline__ const float* xrow(const Params& p, int row) { return row < MP ? p.xp + (size_t)row * D : p.xs + (size_t)(row - MP) * D; }

__device__ __forceinline__ void tr_item(const float* src, int ld, int col0, int k0, bf16_t* dst, int pitch, int row0, int nvalid, float* scr, int lane) {
#pragma unroll 8
    for (int i = 0; i < 32; ++i) { const int kk = 2 * i + (lane >> 5), n = lane & 31; scr[kk * 33 + n] = (n < nvalid) ? src[(size_t)(k0 + kk) * ld + col0 + n] : 0.f; }
    __builtin_amdgcn_s_waitcnt(0); __builtin_amdgcn_wave_barrier();
    const int c = lane & 7;
#pragma unroll
    for (int j = 0; j < 4; ++j) { const int n = (lane >> 3) + 8 * j; const float* s = scr + (8 * c) * 33 + n;
        u32x4 o; o.x = pk2(s[0 * 33], s[1 * 33]); o.y = pk2(s[2 * 33], s[3 * 33]); o.z = pk2(s[4 * 33], s[5 * 33]); o.w = pk2(s[6 * 33], s[7 * 33]);
        if (n < nvalid) *(u32x4*)(dst + (size_t)(row0 + n) * pitch + k0 + 8 * c) = o; }
    __builtin_amdgcn_s_waitcnt(0); __builtin_amdgcn_wave_barrier();
}
__device__ __forceinline__ void convert_weights(const Params& p, float* scr, int gw, int NGW, int lane) {
    bf16_t* Win = (bf16_t*)(p.ws + WS_WIN); bf16_t* Wup = (bf16_t*)(p.ws + WS_WUP); bf16_t* Wpool = (bf16_t*)(p.ws + WS_WPOOL);
    bf16_t* Wout = (bf16_t*)(p.ws + WS_WOUT); bf16_t* Wff1 = (bf16_t*)(p.ws + WS_WFF1); bf16_t* Wff2 = (bf16_t*)(p.ws + WS_WFF2);
    constexpr int NB_IN = 257;
    constexpr int I_IN = (D / 64) * NB_IN, I_UP = (AW / 64) * (D / 32), I_POOL = 4 * (256 / 64) * (512 / 32), I_OUT = (D / 64) * (D / 32), I_FF1 = (D / 64) * (FF / 32), I_FF2 = (FF / 64) * (D / 32);
    constexpr int NITEMS = I_IN + I_UP + I_POOL + I_OUT + I_FF1 + I_FF2;
    for (int it = gw; it < NITEMS; it += NGW) {
        int r = it;
        if (r < I_IN) { const int kb = r / NB_IN, nb = r % NB_IN, r0 = nb * 32;
            const int c0 = r0 < 3072 ? r0 : (r0 < NMAIN ? r0 + 16 : 3072 + (r0 - NMAIN));
            tr_item(p.w_in, 8208, c0, kb * 64, Win, D, r0, r0 < NMAIN ? 32 : 16, scr, lane); continue; }
        r -= I_IN;
        if (r < I_UP) { const int nblk = D / 32; tr_item(p.w_up, D, (r % nblk) * 32, (r / nblk) * 64, Wup, AW, (r % nblk) * 32, 32, scr, lane); continue; }
        r -= I_UP;
        if (r < I_POOL) { const int g = r / 64, q = r % 64, kb = q / 16, nb = q % 16;
            tr_item(p.w_pool + (size_t)g * 256 * 512, 512, nb * 32, kb * 64, Wpool, 256, g * 512 + nb * 32, 32, scr, lane); continue; }
        r -= I_POOL;
        if (r < I_OUT) { const int nblk = D / 32; tr_item(p.w_out, D, (r % nblk) * 32, (r / nblk) * 64, Wout, D, (r % nblk) * 32, 32, scr, lane); continue; }
        r -= I_OUT;
        if (r < I_FF1) { const int nblk = FF / 32; tr_item(p.w_ff1, FF, (r % nblk) * 32, (r / nblk) * 64, Wff1, D, (r % nblk) * 32, 32, scr, lane); continue; }
        r -= I_FF1;
        { const int nblk = D / 32; tr_item(p.w_ff2, D, (r % nblk) * 32, (r / nblk) * 64, Wff2, FF, (r % nblk) * 32, 32, scr, lane); }
    }
}
__device__ __forceinline__ void rms_row_to_bf16(const float* xr_, const float* g, bf16_t* orow, int lane) {
    const f32x4* xr = (const f32x4*)xr_ + lane; const f32x4* gr = (const f32x4*)g + lane;
    f32x4 v[8]; float s = 0.f;
#pragma unroll
    for (int j = 0; j < 8; ++j) { v[j] = xr[64 * j]; s += (v[j].x * v[j].x + v[j].y * v[j].y) + (v[j].z * v[j].z + v[j].w * v[j].w); }
    const float rstd = rsqrtf(wave_sum(s) * (1.f / D) + EPS);
    u32x2* o8 = (u32x2*)orow + lane;
#pragma unroll
    for (int j = 0; j < 8; ++j) { const f32x4 gg = gr[64 * j]; u32x2 w; w.x = pk2(v[j].x * rstd * gg.x, v[j].y * rstd * gg.y); w.y = pk2(v[j].z * rstd * gg.z, v[j].w * rstd * gg.w); o8[64 * j] = w; }
}
template <int WM, int WN, int TM, int TN, class Epi>
__device__ __forceinline__ void sgemm_tile(unsigned char* smem, const bf16_t* __restrict__ A, int lda, const bf16_t* __restrict__ Bt, int ldb, int K, int row0, int col0, const Epi& E) {
    static_assert(WM * WN == 8, "8 waves");
    constexpr int BM = WM * TM * 16, BN = WN * TN * 16, CA = BM * 8, CB = BN * 8, NA = (CA + 511) / 512, NB = (CB + 511) / 512;
    const int tid = threadIdx.x, lane = tid & 63, wid = tid >> 6, wr = wid / WN, wc = wid % WN, fr = lane & 15, fq = lane >> 4;
    unsigned char* sA = smem; unsigned char* sB = smem + BM * 128;
    f32x4 acc[TM][TN];
#pragma unroll
    for (int m = 0; m < TM; ++m)
#pragma unroll
        for (int n = 0; n < TN; ++n) acc[m][n] = (f32x4){0.f, 0.f, 0.f, 0.f};
    u32x4 ra[NA], rb[NB];
    const int nk = K / 64;
#define SG_GLOAD(kt) do { \
    _Pragma("unroll") for (int i = 0; i < NA; ++i) { const int c = tid + i * 512; if (c < CA) ra[i] = *(const u32x4*)(A + (size_t)(row0 + (c >> 3)) * lda + (kt) * 64 + (c & 7) * 8); } \
    _Pragma("unroll") for (int i = 0; i < NB; ++i) { const int c = tid + i * 512; if (c < CB) rb[i] = *(const u32x4*)(Bt + (size_t)(col0 + (c >> 3)) * ldb + (kt) * 64 + (c & 7) * 8); } } while (0)
    SG_GLOAD(0);
    for (int kt = 0; kt < nk; ++kt) {
        __syncthreads();
#pragma unroll
        for (int i = 0; i < NA; ++i) { const int c = tid + i * 512; if (c < CA) { const int r = c >> 3, ch = c & 7; *(u32x4*)(sA + r * 128 + ((ch ^ (r & 7)) << 4)) = ra[i]; } }
#pragma unroll
        for (int i = 0; i < NB; ++i) { const int c = tid + i * 512; if (c < CB) { const int r = c >> 3, ch = c & 7; *(u32x4*)(sB + r * 128 + ((ch ^ (r & 7)) << 4)) = rb[i]; } }
        __syncthreads();
        if (kt + 1 < nk) SG_GLOAD(kt + 1);
#pragma unroll
        for (int kk = 0; kk < 2; ++kk) {
            bf16x8 af[TM], bfr[TN];
#pragma unroll
            for (int m = 0; m < TM; ++m) { const int r = (wr * TM + m) * 16 + fr, ch = kk * 4 + fq; af[m] = *(const bf16x8*)(sA + r * 128 + ((ch ^ (r & 7)) << 4)); }
#pragma unroll
            for (int n = 0; n < TN; ++n) { const int r = (wc * TN + n) * 16 + fr, ch = kk * 4 + fq; bfr[n] = *(const bf16x8*)(sB + r * 128 + ((ch ^ (r & 7)) << 4)); }
#pragma unroll
            for (int m = 0; m < TM; ++m)
#pragma unroll
                for (int n = 0; n < TN; ++n) acc[m][n] = __builtin_amdgcn_mfma_f32_16x16x32_bf16(bfr[n], af[m], acc[m][n], 0, 0, 0);
        }
    }
#undef SG_GLOAD
#pragma unroll
    for (int m = 0; m < TM; ++m)
#pragma unroll
        for (int n = 0; n < TN; ++n) E(row0 + (wr * TM + m) * 16 + fr, col0 + (wc * TN + n) * 16 + 4 * fq, acc[m][n]);
}

__device__ __forceinline__ void st_bf16x4(bf16_t* p, f32x4 v) { u32x2 w; w.x = pk2(v.x, v.y); w.y = pk2(v.z, v.w); *(u32x2*)p = w; }
__device__ __forceinline__ f32x4 ld_bf16x4(const bf16_t* p) { const u32x2 w = *(const u32x2*)p; return (f32x4){bflo(w.x), bfhi(w.x), bflo(w.y), bfhi(w.y)}; }

struct EpiIn {
    bf16_t *Q, *Kb, *Vb, *U, *SA, *SB; float* out; const float* pscale;
    __device__ __forceinline__ void operator()(int row, int col, f32x4 v) const {
        if (col < C_K) { st_bf16x4(Q + (size_t)row * AW + col, v * QSCALE); }
        else if (col < C_U) {
            const bool isk = col < C_V; const int c = col - (isk ? C_K : C_V);
            st_bf16x4((isk ? Kb : Vb) + (size_t)row * AW + c, v);
            float* o = row < MP ? out + (isk ? O_KP : O_VP) + (size_t)row * AW + c : out + (isk ? O_KS : O_VS) + (size_t)(row - MP) * AW + c;
            *(f32x4*)o = v;
        } else if (col < C_GA) {
            const int c = col - C_U; st_bf16x4(U + (size_t)row * PW + c, v);
            if (row < MP) { const int b = row / SEQ, t = row % SEQ; if (t >= SEQ - 15) *(f32x4*)(out + O_PP + ((size_t)b * 15 + (t - (SEQ - 15))) * PW + c) = v; }
            else { const int rs = row - MP, b = rs / SN, i = rs % SN; if (i >= 1) *(f32x4*)(out + O_PS + ((size_t)b * 15 + (i - 1)) * PW + c) = v; }
        } else if (col < C_GB) { const int c = col - C_GA; f32x4 s = {sigmoidf_(v.x), sigmoidf_(v.y), sigmoidf_(v.z), sigmoidf_(v.w)}; st_bf16x4(SA + (size_t)row * D + c, s); }
        else { const int c = col - C_GB; const f32x4 ps = *(const f32x4*)(pscale + c); f32x4 s = {sigmoidf_(v.x) * ps.x, sigmoidf_(v.y) * ps.y, sigmoidf_(v.z) * ps.z, sigmoidf_(v.w) * ps.w}; st_bf16x4(SB + (size_t)row * D + c, s); }
    }
};
struct EpiLogf {
    float* LOGF; float* out; const float* b_f;
    __device__ __forceinline__ void operator()(int row, int col, f32x4 v) const {
        const f32x4 b = *(const f32x4*)(b_f + col); f32x4 r;
#pragma unroll
        for (int e = 0; e < 4; ++e) { const float z = v[e] + b[e]; r[e] = fminf(z, 0.f) - log1pf(__expf(-fabsf(z))); }
        *(f32x4*)(LOGF + (size_t)row * NH + col) = r;
        float* o = row < MP ? out + O_LP + (size_t)row * NH + col : out + O_LS + (size_t)(row - MP) * NH + col;
        *(f32x4*)o = r;
    }
};
__device__ __forceinline__ float wave_incl_scan(float v, int lane) {
#pragma unroll
    for (int o = 1; o < 64; o <<= 1) { const float t = __shfl_up(v, o); if (lane >= o) v += t; }
    return v;
}
__device__ __forceinline__ void pool_chunk(const Params& p, int row, int ch) {
    const bf16_t* U = (const bf16_t*)(p.ws + WS_U); bf16_t* PO = (bf16_t*)(p.ws + WS_PO);
    const int c0 = ch * 8, g = c0 >> 8, w = 2 << g;
    float s[8]; float cur[8];
#pragma unroll
    for (int e = 0; e < 8; ++e) s[e] = 0.f;
    float cnt;
    if (row < MP) { const int t = row % SEQ; const int n = (t + 1 < w) ? t + 1 : w; cnt = (float)n;
        for (int j = 0; j < n; ++j) { const u32x4 v = *(const u32x4*)(U + (size_t)(row - j) * PW + c0);
            const float f[8] = {bflo(v.x), bfhi(v.x), bflo(v.y), bfhi(v.y), bflo(v.z), bfhi(v.z), bflo(v.w), bfhi(v.w)};
#pragma unroll
            for (int e = 0; e < 8; ++e) { s[e] += f[e]; if (j == 0) cur[e] = f[e]; } }
    } else { const int rs = row - MP, b = rs / SN, i = rs % SN; cnt = (float)w;
        for (int j = 0; j < w; ++j) { const int e_ = 15 + i - j;
            float f[8];
            if (e_ >= 15) { const u32x4 v = *(const u32x4*)(U + (size_t)(MP + b * SN + (e_ - 15)) * PW + c0);
                f[0] = bflo(v.x); f[1] = bfhi(v.x); f[2] = bflo(v.y); f[3] = bfhi(v.y); f[4] = bflo(v.z); f[5] = bfhi(v.z); f[6] = bflo(v.w); f[7] = bfhi(v.w); }
            else { const f32x4 a = *(const f32x4*)(p.sp + ((size_t)b * 15 + e_) * PW + c0), c = *(const f32x4*)(p.sp + ((size_t)b * 15 + e_) * PW + c0 + 4);
                f[0] = a.x; f[1] = a.y; f[2] = a.z; f[3] = a.w; f[4] = c.x; f[5] = c.y; f[6] = c.z; f[7] = c.w; }
#pragma unroll
            for (int e = 0; e < 8; ++e) { s[e] += f[e]; if (j == 0) cur[e] = f[e]; } }
    }
    u32x4 o; o.x = pk2(s[0] / cnt - cur[0], s[1] / cnt - cur[1]); o.y = pk2(s[2] / cnt - cur[2], s[3] / cnt - cur[3]); o.z = pk2(s[4] / cnt - cur[4], s[5] / cnt - cur[5]); o.w = pk2(s[6] / cnt - cur[6], s[7] / cnt - cur[7]);
    *(u32x4*)(PO + (size_t)row * PW + c0) = o;
}
struct EpiPool { const bf16_t* SB; bf16_t* T;
    __device__ __forceinline__ void operator()(int row, int col, f32x4 v) const { const f32x4 s = ld_bf16x4(SB + (size_t)row * D + col); st_bf16x4(T + (size_t)row * D + col, v * s); } };
struct EpiUp { const bf16_t* SA; bf16_t* T;
    __device__ __forceinline__ void operator()(int row, int col, f32x4 v) const { const f32x4 s = ld_bf16x4(SA + (size_t)row * D + col), t = ld_bf16x4(T + (size_t)row * D + col); st_bf16x4(T + (size_t)row * D + col, v * s + t); } };
struct EpiF32 { float* C; int ldc;
    __device__ __forceinline__ void operator()(int row, int col, f32x4 v) const { *(f32x4*)(C + (size_t)row * ldc + col) = v; } };
struct EpiRelu2 { bf16_t* Z;
    __device__ __forceinline__ void operator()(int row, int col, f32x4 v) const { f32x4 r;
#pragma unroll
        for (int e = 0; e < 4; ++e) { const float a = fmaxf(v[e], 0.f); r[e] = a * a; }
        st_bf16x4(Z + (size_t)row * FF + col, r); } };

namespace pg8 {
#define PG8_LAS __attribute__((address_space(3)))


constexpr int BM = 256, BK = 64, HALF = 128, HTB = HALF * BK * 2  , STAGE_BYTES = 8 * HTB, NXCD = 8, WGM = 8;

__host__ __device__ __forceinline__ int lds_byte(int r, int c) { const int st = (r >> 4) * 2 + (c >> 5), rr = r & 15, cc = c & 31, ob = rr * 64 + cc * 2; return st * 1024 + (ob ^ (((ob >> 9) & 1) << 5)); }
__host__ __device__ __forceinline__ void stage_rc(int b, int& R, int& C) { const int st = b / 1024, sb = b % 1024, swz = sb ^ (((sb >> 9) & 1) << 5); R = (st >> 1) * 16 + swz / 64; C = (st & 1) * 32 + (swz % 64) / 2; }
__host__ __device__ __forceinline__ int perm32(int rho) { const int n = rho >> 4, i = rho & 15; return 8 * (i >> 2) + 4 * n + (i & 3); }

struct Unit { int pm, pn; };
struct Gemm { const bf16_t* A; const bf16_t* Bt; int M, N, K, lda, agrp; };

struct StaticOrder {
    int nM, nN, nwg, G, c;
    __host__ __device__ void init(int M, int N, int G_, int c_) { nM = M / BM; nN = N / BM; nwg = nM * nN; G = G_; c = c_; }
    __host__ __device__ bool next(int i, Unit& u) const {
        const long L = (long)i * G + c; if (L >= nwg) return false;
        int wgid = (int)L; { const int q = nwg / NXCD, r = nwg % NXCD, xcd = wgid % NXCD, off = wgid / NXCD; wgid = (xcd < r ? xcd * (q + 1) : r * (q + 1) + (xcd - r) * q) + off; }
        const int nig = WGM * nN, gid = wgid / nig, fm = gid * WGM, gsz = (nM - fm) < WGM ? (nM - fm) : WGM;
        u.pm = fm + ((wgid % nig) % gsz); u.pn = (wgid % nig) / gsz; return true;
    }
    __device__ __forceinline__ void a_ready(const Unit&) const {}
    __device__ __forceinline__ void done(const Unit&) const {}
};

template <class Epi, class Sched, bool ALIGN_EPI = false, bool SP2 = false>
__device__ __forceinline__ void gemm_phase(PG8_LAS unsigned char* lds, const Gemm g, const Sched& S, const Epi& E) {
    const int tid = threadIdx.x, wid = __builtin_amdgcn_readfirstlane(tid >> 6), lane = tid & 63, wr = wid >> 2, wc = wid & 3, fr = lane & 15, fq = lane >> 4;
    const int K = g.K, nt = K / BK;
    unsigned voffA[2], voffB[2];
#pragma unroll
    for (int i = 0; i < 2; ++i) { int R, C; stage_rc(tid * 16 + i * 8192, R, C); const int Rb = Epi::PERM ? ((R & ~31) + perm32(R & 31)) : R;
        voffA[i] = (unsigned)(R * g.lda + C) * 2u; voffB[i] = (unsigned)(Rb * K + C) * 2u; }
    const size_t kstep = (size_t)(BK * 2);
    const size_t hstepA = (size_t)HALF * g.lda * 2, hstepB = (size_t)HALF * K * 2;
    const size_t tstepA = 2 * hstepA, tstepB = 2 * hstepB;
    const unsigned ldsw = (unsigned)wid * 1024u;
    const int aoff = lds_byte(wr * 64 + fr, fq * 8), boff = lds_byte(wc * 32 + fr, fq * 8);
#define PG8_SA(b, h) (((b) * 2 + (h)) * HTB)
#define PG8_SB(b, h) ((4 + (b) * 2 + (h)) * HTB)
#define PG8_STAGE(bufoff, gbase, voff) do { _Pragma("unroll") for (int _i = 0; _i < 2; ++_i) \
        __builtin_amdgcn_global_load_lds((const unsigned*)((const char*)(gbase) + (voff)[_i]), (PG8_LAS unsigned*)(lds + (bufoff) + ldsw + _i * 8192), 16, 0, 0); } while (0)
#define PG8_LDA(dst, b, h) do { _Pragma("unroll") for (int m = 0; m < 4; ++m) _Pragma("unroll") for (int k = 0; k < 2; ++k) dst[m][k] = *(const PG8_LAS bf16x8*)(lds + PG8_SA(b, h) + aoff + m * 2048 + k * 1024); } while (0)
#define PG8_LDB(dst, b, h) do { _Pragma("unroll") for (int n = 0; n < 2; ++n) _Pragma("unroll") for (int k = 0; k < 2; ++k) dst[n][k] = *(const PG8_LAS bf16x8*)(lds + PG8_SB(b, h) + boff + n * 2048 + k * 1024); } while (0)
#define PG8_MMA(ai, bj, At, Bt) do { __builtin_amdgcn_s_setprio(1); _Pragma("unroll") for (int m = 0; m < 4; ++m) _Pragma("unroll") for (int n = 0; n < 2; ++n) _Pragma("unroll") for (int k = 0; k < 2; ++k) \
        acc[ai][bj][m][n] = __builtin_amdgcn_mfma_f32_16x16x32_bf16(Bt[n][k], At[m][k], acc[ai][bj][m][n], 0, 0, 0); __builtin_amdgcn_s_setprio(0); } while (0)
#define PG8_WAIT_V(n) asm volatile("s_waitcnt vmcnt(" #n ")" ::: "memory")
#define PG8_WAIT_L(n) asm volatile("s_waitcnt lgkmcnt(" #n ")" ::: "memory")
#define PG8_BAR __builtin_amdgcn_s_barrier()
#define PG8_SCHED __builtin_amdgcn_sched_barrier(0)
    Unit cur, nxt; int ui = 0;
    if (!S.next(0, cur)) return;
    f32x4 acc[2][2][4][2];
#pragma unroll
    for (int a = 0; a < 2; ++a)
#pragma unroll
        for (int b = 0; b < 2; ++b)
#pragma unroll
            for (int m = 0; m < 4; ++m)
#pragma unroll
                for (int n = 0; n < 2; ++n) acc[a][b][m][n] = (f32x4){0.f, 0.f, 0.f, 0.f};
    bf16x8 At[4][2], B0[2][2], B1[2][2];
    const char* cA = (const char*)g.A + (size_t)cur.pm * tstepA + (size_t)((cur.pn >> 1) * g.agrp) * 2; const char* cB = (const char*)g.Bt + (size_t)cur.pn * tstepB;
    S.a_ready(cur);
    if constexpr (SP2) {
        PG8_STAGE(PG8_SB(0, 0), cB, voffB); PG8_STAGE(PG8_SB(0, 1), cB + hstepB, voffB); PG8_STAGE(PG8_SA(0, 0), cA, voffA); PG8_STAGE(PG8_SA(0, 1), cA + hstepA, voffA);
        if (wr == 1) PG8_BAR;
        PG8_WAIT_V(2); PG8_BAR;
        PG8_STAGE(PG8_SB(1, 0), cB + kstep, voffB); PG8_STAGE(PG8_SA(1, 0), cA + kstep, voffA); PG8_STAGE(PG8_SB(1, 1), cB + hstepB + kstep, voffB);
        PG8_WAIT_V(6); PG8_BAR;
    } else {
        PG8_STAGE(PG8_SB(0, 0), cB, voffB); PG8_STAGE(PG8_SA(0, 0), cA, voffA); PG8_STAGE(PG8_SB(0, 1), cB + hstepB, voffB); PG8_STAGE(PG8_SA(0, 1), cA + hstepA, voffA);
        if (wr == 1) PG8_BAR;
        PG8_WAIT_V(4); PG8_BAR;
        PG8_STAGE(PG8_SB(1, 0), cB + kstep, voffB); PG8_STAGE(PG8_SA(1, 0), cA + kstep, voffA); PG8_STAGE(PG8_SB(1, 1), cB + hstepB + kstep, voffB);
        PG8_WAIT_V(6); PG8_BAR;
    }
    for (;;) {
        const bool has_next = S.next(ui + 1, nxt);
        const char* nA = has_next ? (const char*)g.A + (size_t)nxt.pm * tstepA + (size_t)((nxt.pn >> 1) * g.agrp) * 2 : cA; const char* nB = has_next ? (const char*)g.Bt + (size_t)nxt.pn * tstepB : cB;
        for (int t = 0; t < nt; t += 2) {
            const bool last = (t == nt - 2);
            const char* a1 = cA + (size_t)(t + 1) * kstep;
            const char* a2 = last ? nA : cA + (size_t)(t + 2) * kstep; const char* b2 = last ? nB : cB + (size_t)(t + 2) * kstep;
            const char* a3 = a2 + kstep; const char* b3 = b2 + kstep;
            if (last && has_next) S.a_ready(nxt);
            if constexpr (SP2) {
            PG8_LDB(B0, 0, 0); PG8_LDB(B1, 0, 1); PG8_SCHED; PG8_LDA(At, 0, 0); PG8_STAGE(PG8_SA(1, 1), a1 + hstepA, voffA);
            PG8_WAIT_V(8); PG8_WAIT_L(0); PG8_BAR; PG8_MMA(0, 0, At, B0); PG8_MMA(0, 1, At, B1); PG8_BAR; PG8_SCHED;
            PG8_LDA(At, 0, 1); PG8_STAGE(PG8_SB(0, 0), b2, voffB); PG8_STAGE(PG8_SB(0, 1), b2 + hstepB, voffB); PG8_STAGE(PG8_SA(0, 0), a2, voffA);
            PG8_WAIT_V(8); PG8_WAIT_L(0); PG8_BAR; PG8_MMA(1, 0, At, B0); PG8_MMA(1, 1, At, B1); PG8_BAR; PG8_SCHED;
            PG8_LDB(B0, 1, 0); PG8_LDB(B1, 1, 1); PG8_SCHED; PG8_LDA(At, 1, 0); PG8_STAGE(PG8_SA(0, 1), a2 + hstepA, voffA);
            PG8_WAIT_V(8); PG8_WAIT_L(0); PG8_BAR; PG8_MMA(0, 0, At, B0); PG8_MMA(0, 1, At, B1); PG8_BAR; PG8_SCHED;
            PG8_LDA(At, 1, 1); PG8_STAGE(PG8_SB(1, 0), b3, voffB); PG8_STAGE(PG8_SB(1, 1), b3 + hstepB, voffB); PG8_STAGE(PG8_SA(1, 0), a3, voffA);
            PG8_WAIT_V(8); PG8_WAIT_L(0); PG8_BAR; PG8_MMA(1, 0, At, B0); PG8_MMA(1, 1, At, B1); PG8_BAR; PG8_SCHED;
            } else {
            PG8_LDB(B0, 0, 0); PG8_SCHED; PG8_LDA(At, 0, 0); PG8_STAGE(PG8_SA(1, 1), a1 + hstepA, voffA);
            PG8_WAIT_L(8); PG8_BAR; PG8_WAIT_L(0); PG8_MMA(0, 0, At, B0); PG8_BAR; PG8_SCHED;
            PG8_LDB(B1, 0, 1); PG8_STAGE(PG8_SB(0, 0), b2, voffB);
            PG8_BAR; PG8_WAIT_L(0); PG8_MMA(0, 1, At, B1); PG8_BAR;
            PG8_LDA(At, 0, 1); PG8_STAGE(PG8_SA(0, 0), a2, voffA);
            PG8_BAR; PG8_WAIT_L(0); PG8_MMA(1, 0, At, B0); PG8_BAR; PG8_SCHED;
            PG8_STAGE(PG8_SB(0, 1), b2 + hstepB, voffB);
            PG8_WAIT_V(6); PG8_BAR; PG8_MMA(1, 1, At, B1); PG8_BAR;
            PG8_LDB(B0, 1, 0); PG8_SCHED; PG8_LDA(At, 1, 0); PG8_STAGE(PG8_SA(0, 1), a2 + hstepA, voffA);
            PG8_WAIT_L(8); PG8_BAR; PG8_WAIT_L(0); PG8_MMA(0, 0, At, B0); PG8_BAR; PG8_SCHED;
            PG8_LDB(B1, 1, 1); PG8_STAGE(PG8_SB(1, 0), b3, voffB);
            PG8_BAR; PG8_WAIT_L(0); PG8_MMA(0, 1, At, B1); PG8_BAR;
            PG8_LDA(At, 1, 1); PG8_STAGE(PG8_SA(1, 0), a3, voffA);
            PG8_BAR; PG8_WAIT_L(0); PG8_MMA(1, 0, At, B0); PG8_BAR; PG8_SCHED;
            PG8_STAGE(PG8_SB(1, 1), b3 + hstepB, voffB);
            PG8_WAIT_V(6); PG8_BAR; PG8_MMA(1, 1, At, B1); PG8_BAR;
            }
        }
        if constexpr (ALIGN_EPI) { if (wr == 0) PG8_BAR; }
        if constexpr (!Epi::AFTER_DRAIN) { E(acc, cur, wr, wc, fr, fq); S.done(cur); }
        if (!has_next) break;
#pragma unroll
        for (int a = 0; a < 2; ++a)
#pragma unroll
            for (int b = 0; b < 2; ++b)
#pragma unroll
                for (int m = 0; m < 4; ++m)
#pragma unroll
                    for (int n = 0; n < 2; ++n) acc[a][b][m][n] = (f32x4){0.f, 0.f, 0.f, 0.f};
        cur = nxt; cA = nA; cB = nB; ++ui;
        if constexpr (ALIGN_EPI) { if (wr == 1) PG8_BAR; }
    }
    PG8_WAIT_V(0);
    if constexpr (!ALIGN_EPI) { if (wr == 0) PG8_BAR; }
    PG8_BAR;
    if constexpr (Epi::AFTER_DRAIN) { E.fused(acc, cur, wr, wc, fr, fq, lds, wid, lane); S.done(cur); }
#undef PG8_SA
#undef PG8_SB
#undef PG8_STAGE
#undef PG8_LDA
#undef PG8_LDB
#undef PG8_MMA
#undef PG8_WAIT_V
#undef PG8_WAIT_L
#undef PG8_BAR
#undef PG8_SCHED
}
}

#include <hip/hip_bf16.h>
#include <cmath>
namespace attn_body {
using bf16=__hip_bfloat16;
using bf16x8=__attribute__((ext_vector_type(8)))short;
using s16x4=__attribute__((ext_vector_type(4)))short;
using f32x16=__attribute__((ext_vector_type(16)))float;
using u32x4=__attribute__((ext_vector_type(4)))unsigned;
constexpr int BATCH=8,NHEAD=16,SEQ=2048,D=64,DM=NHEAD*D;
constexpr int NW=8,QBLK=32,QB=QBLK*NW,KVBLK=64,NQB=SEQ/QB;
constexpr int ATTN_PITCH=DM, ATTN_UNIT_ROWS=QB;
__device__ __forceinline__ int crow(int r,int hi){return (r&3)+8*(r>>2)+4*hi;}
#define SBAR() __builtin_amdgcn_sched_barrier(0)
__device__ __forceinline__ void cmask(f32x16&p0,f32x16&p1,int jb,int qrel,int hi){
  const float NEG=-INFINITY; int kb=64*jb+4*hi;
  #pragma unroll
  for(int r=0;r<16;++r){int kv=kb+(r&3)+8*(r>>2); if(kv>qrel)p0[r]=NEG; if(kv+32>qrel)p1[r]=NEG;}
}

constexpr int NSLOT=3, SLOTB=8192;
constexpr int LDS_K=0, LDS_V=NSLOT*SLOTB, LDS_WS=2*NSLOT*SLOTB, LDS_OST=LDS_WS+NW*64*4, LDS_BYTES=LDS_OST+NW*4096;
constexpr float C2=0.125f*1.4426950408889634f;
__device__ __forceinline__ void glds16(const void*gsrc,unsigned lds_dst){unsigned keep;
  asm volatile("s_mov_b32 %0, m0\n\ts_mov_b32 m0, %2\n\ts_nop 0\n\tglobal_load_lds_dwordx4 %1, off\n\ts_mov_b32 m0, %0":"=&s"(keep):"v"(gsrc),"s"(lds_dst):"memory");}
__device__ __forceinline__ float max3f(float a,float b,float c){float r;asm("v_max3_f32 %0, %1, %2, %3":"=v"(r):"v"(a),"v"(b),"v"(c));return r;}
__device__ __forceinline__ float max2f(float a,float b){float r;asm("v_max_f32_e32 %0, %1, %2":"=v"(r):"v"(a),"v"(b));return r;}
__device__ __forceinline__ float fadd_s(float a,float b){float r;asm("v_add_f32_e32 %0, %1, %2":"=v"(r):"v"(a),"v"(b));return r;}
__device__ __forceinline__ float fsub_s(float a,float b){float r;asm("v_sub_f32_e32 %0, %1, %2":"=v"(r):"v"(a),"v"(b));return r;}
typedef float f32x2_t __attribute__((ext_vector_type(2))); typedef __bf16 bf16x2_t __attribute__((ext_vector_type(2)));
__device__ __forceinline__ unsigned cvtpk_s(float lo,float hi){f32x2_t v={lo,hi};bf16x2_t b=__builtin_convertvector(v,bf16x2_t);return __builtin_bit_cast(unsigned,b);}
#define WAIT_BAR(N) asm volatile("s_waitcnt vmcnt(" #N ") lgkmcnt(0)\n\ts_barrier":::"memory")

__device__ __forceinline__ void qkt(f32x16&p0,f32x16&p1,const char*Kslot,const bf16x8*qr,int r32,int hi){
  const char*kb=Kslot+hi*1024+r32*16;
  #pragma unroll
  for(int d0=0;d0<4;++d0){
    const bf16x8 b0=*reinterpret_cast<const bf16x8*>(kb+d0*2048);
    const bf16x8 b1=*reinterpret_cast<const bf16x8*>(kb+d0*2048+512);
    if(d0==0){p0=__builtin_amdgcn_mfma_f32_32x32x16_bf16(b0,qr[0],p0,0,0,0);p1=__builtin_amdgcn_mfma_f32_32x32x16_bf16(b1,qr[0],p1,0,0,0);}
    else{p0=__builtin_amdgcn_mfma_f32_32x32x16_bf16(b0,qr[d0],p0,0,0,0);p1=__builtin_amdgcn_mfma_f32_32x32x16_bf16(b1,qr[d0],p1,0,0,0);}}
}
typedef __attribute__((address_space(3))) const char* lds_cptr;
typedef short v4i16_t __attribute__((ext_vector_type(4)));
__device__ __forceinline__ void kload8(bf16x8*kf,lds_cptr kp){
  kf[0]=*(const __attribute__((address_space(3))) bf16x8*)(kp);      kf[1]=*(const __attribute__((address_space(3))) bf16x8*)(kp+512);
  kf[2]=*(const __attribute__((address_space(3))) bf16x8*)(kp+2048); kf[3]=*(const __attribute__((address_space(3))) bf16x8*)(kp+2560);
  kf[4]=*(const __attribute__((address_space(3))) bf16x8*)(kp+4096); kf[5]=*(const __attribute__((address_space(3))) bf16x8*)(kp+4608);
  kf[6]=*(const __attribute__((address_space(3))) bf16x8*)(kp+6144); kf[7]=*(const __attribute__((address_space(3))) bf16x8*)(kp+6656);
}
__device__ __forceinline__ void kload2(bf16x8*kf,lds_cptr kp,int j){ kf[2*j]=*(const __attribute__((address_space(3))) bf16x8*)(kp+j*2048); kf[2*j+1]=*(const __attribute__((address_space(3))) bf16x8*)(kp+j*2048+512); }
__device__ __forceinline__ s16x4 vtr(lds_cptr p){ return __builtin_bit_cast(s16x4,__builtin_amdgcn_ds_read_tr16_b64_v4i16((__attribute__((address_space(3))) v4i16_t*)p)); }
__device__ __forceinline__ float rowmax(const f32x16&p0,const f32x16&p1){
  float a=max3f(p0[0],p0[1],p1[0]),b=max3f(p0[2],p0[3],p1[1]);a=max3f(a,p1[2],p1[3]);
  #pragma unroll
  for(int r=4;r<16;r+=4){a=max3f(a,p0[r],p0[r+1]);b=max3f(b,p0[r+2],p0[r+3]);a=max3f(a,p1[r],p1[r+1]);b=max3f(b,p1[r+2],p1[r+3]);}
  const float m=max2f(a,b);
  auto rr=__builtin_amdgcn_permlane32_swap(__float_as_uint(m),__float_as_uint(m),false,false);
  return max2f(__uint_as_float(rr[0]),__uint_as_float(rr[1]));
}
__device__ __forceinline__ void pv(f32x16*o,int vb,bf16x8 pa0,bf16x8 pa1,bf16x8 pa2,bf16x8 pa3){
  #pragma unroll
  for(int d0=0;d0<2;++d0){s16x4 lo[4],hi[4];
    #pragma unroll
    for(int ks=0;ks<4;++ks){
      asm volatile("ds_read_b64_tr_b16 %0,%1 offset:%c2":"=&v"(lo[ks]):"v"(vb),"i"(d0*4096+ks*1024):"memory");
      asm volatile("ds_read_b64_tr_b16 %0,%1 offset:%c2":"=&v"(hi[ks]):"v"(vb),"i"(d0*4096+ks*1024+512):"memory");}
    asm volatile("s_waitcnt lgkmcnt(0)":::"memory");SBAR();
    #define PK(k) (bf16x8){lo[k][0],lo[k][1],lo[k][2],lo[k][3],hi[k][0],hi[k][1],hi[k][2],hi[k][3]}
    o[d0]=__builtin_amdgcn_mfma_f32_32x32x16_bf16(pa0,PK(0),o[d0],0,0,0);
    o[d0]=__builtin_amdgcn_mfma_f32_32x32x16_bf16(pa1,PK(1),o[d0],0,0,0);
    o[d0]=__builtin_amdgcn_mfma_f32_32x32x16_bf16(pa2,PK(2),o[d0],0,0,0);
    o[d0]=__builtin_amdgcn_mfma_f32_32x32x16_bf16(pa3,PK(3),o[d0],0,0,0);
    #undef PK
  }
}

#ifndef ATTN_STORE16
#define ATTN_STORE16(p,v) (*(u32x4*)(p)=(v))
#endif
template<int THRL> __device__ __forceinline__ void attn_unit(int b,int h,int qb,const bf16*Q,const bf16*__restrict__ K,const bf16*__restrict__ V,bf16*O,char*shm,int csl_off){
  const int tid=threadIdx.x,lane=tid&63,r32=lane&31,hi=lane>>5; const int wid=__builtin_amdgcn_readfirstlane(tid>>6);
  const long rowbase=(long)b*SEQ; const int q0=qb*QB;
  const bf16*Qw=Q+(rowbase+q0+wid*QBLK)*DM+h*D;
  const bf16*Kh=K+rowbase*DM+h*D,*Vh=V+rowbase*DM+h*D;
  const unsigned lds0=(unsigned)(uintptr_t)shm;
  float*wsf=(float*)(shm+LDS_WS)+wid*64;
  const bf16*ksrc=Kh+(long)lane*DM+wid*8;
  const bf16*vsrc=Vh+(long)(16*(wid&3)+(lane>>2))*DM+(wid>>2)*32+(lane&3)*8;
  const unsigned kdst=lds0+LDS_K+wid*1024, vdst=lds0+LDS_V+wid*1024;
  #define DMA_K(t,slot) glds16(ksrc+(long)(t)*KVBLK*DM,(unsigned)__builtin_amdgcn_readfirstlane(kdst+(slot)))
  #define DMA_V(t,slot) glds16(vsrc+(long)(t)*KVBLK*DM,(unsigned)__builtin_amdgcn_readfirstlane(vdst+(slot)))
  const int vb0=(int)(lds0+LDS_V)+((lane>>4)&1)*32+(lane&3)*8+(4*hi+((lane&15)>>2))*64;
  const char*Kbase=shm+LDS_K; bf16x8 kf[8];
  const lds_cptr shm3=(lds_cptr)shm; const lds_cptr kp0=shm3+LDS_K+hi*1024+r32*16; const lds_cptr vp0=shm3+LDS_V+((lane>>4)&1)*32+(lane&3)*8+(4*hi+((lane&15)>>2))*64;
  const int NT=(q0+QB)/KVBLK;
  DMA_K(0,0);DMA_V(0,0);DMA_K(1,SLOTB);
  bf16x8 qr[4];
  #pragma unroll
  for(int d0=0;d0<4;++d0)qr[d0]=*reinterpret_cast<const bf16x8*>(&Qw[(long)r32*DM+d0*16+hi*8]);
  float mhat=0.f,l_reg=0.f;f32x16 o[2];o[0]=f32x16{};o[1]=f32x16{};
  typedef float f32x4_t __attribute__((ext_vector_type(4)));
  const __attribute__((address_space(3))) float* csl3=(const __attribute__((address_space(3))) float*)((lds_cptr)shm+csl_off);
  float nbase=csl3[q0+wid*QBLK+r32];
  #define BIASFILL(C0,C1,t) do{ const __attribute__((address_space(3))) float* cp_=csl3+(t)*KVBLK+4*hi; \
    _Pragma("unroll") for(int g_=0;g_<4;++g_){ const f32x4_t a_=*(const __attribute__((address_space(3))) f32x4_t*)(cp_+8*g_); const f32x4_t b_=*(const __attribute__((address_space(3))) f32x4_t*)(cp_+32+8*g_); \
      _Pragma("unroll") for(int e_=0;e_<4;++e_){ C0[4*g_+e_]=nbase-a_[e_]; C1[4*g_+e_]=nbase-b_[e_]; } } }while(0)
  const int qrel=wid*QBLK+r32;
  #define CMASK(P0,P1,t) do{int jb_=(t)-(NT-4); if(jb_>=0)cmask(P0,P1,jb_,qrel,hi);}while(0)
  bool resc=false;
  #define START(P0,P1) do{ const float rm=rowmax(P0,P1); resc=false; \
    { const float dl=rm; mhat=fadd_s(mhat,dl); \
      _Pragma("unroll") for(int r=0;r<16;++r){P0[r]=fsub_s(P0[r],dl);P1[r]=fsub_s(P1[r],dl);} \
      nbase=fsub_s(nbase,dl); } \
    _Pragma("unroll") for(int r=0;r<16;++r)P0[r]=__builtin_amdgcn_exp2f(P0[r]); }while(0)
  #define RESC() do{ if(resc){ asm volatile("s_waitcnt lgkmcnt(0)":::"memory"); \
      _Pragma("unroll") for(int d_=0;d_<2;++d_) _Pragma("unroll") for(int r=0;r<16;++r)o[d_][r]*=wsf[crow(r,hi)]; } }while(0)
  f32x16 pA0,pA1,pB0,pB1;
  int sl_prev=0,sl_cur=0,sl_next=SLOTB;
  #define ROT() do{sl_prev=sl_cur;sl_cur=sl_next;sl_next=(sl_next==(NSLOT-1)*SLOTB)?0:sl_next+SLOTB;}while(0)
  DMA_K(2,2*SLOTB);
  WAIT_BAR(3);
  BIASFILL(pA0,pA1,0);
  qkt(pA0,pA1,Kbase,qr,r32,hi);asm volatile("s_nop 15\n\ts_nop 7":"+v"(pA0),"+v"(pA1));CMASK(pA0,pA1,0);
  START(pA0,pA1);
  BIASFILL(pB0,pB1,1);
  _Pragma("unroll") for(int r=0;r<16;++r)pA1[r]=__builtin_amdgcn_exp2f(pA1[r]);
  WAIT_BAR(0);
  DMA_K(3,0);DMA_V(1,SLOTB);
  ROT();
  kload8(kf,kp0+sl_cur);
  WAIT_BAR(2);
  s16x4 vlo[8],vhi[8]; u32x4 pw0,pw1,pw2,pw3;
  #define PKW(P,B) cvtpk_s(P[B],P[B+1])
  #define PAF(k) __builtin_bit_cast(bf16x8,pw##k)
  #define VFR(i) (bf16x8){vlo[i][0],vlo[i][1],vlo[i][2],vlo[i][3],vhi[i][0],vhi[i][1],vhi[i][2],vhi[i][3]}
  #define PIN(x) asm volatile("":"+v"(x))
  #define MX3(a,b,c) __builtin_fmaxf(__builtin_fmaxf((a),(b)),(c))
  #define GAPA(MF,A0,A1,A2,A3,W0,W1,PW) do{ MF; sacc+=A0; sacc+=A1; sacc+=A2; sacc+=A3; PIN(sacc); W0; W1; PIN(PW); SBAR(); }while(0)
  #define EX(v) __builtin_amdgcn_exp2f(v)
  #define GAPB(MF,X,B) do{ MF; X[B]=EX(X[B]); X[B+1]=EX(X[B+1]); X[B+2]=EX(X[B+2]); X[B+3]=EX(X[B+3]); PIN(X); SBAR(); }while(0)
  #define VRD(i) do{ vlo[i]=vtr(vp_+(((i)>>2)*4096+((i)&3)*1024)); vhi[i]=vtr(vp_+(((i)>>2)*4096+((i)&3)*1024+512)); }while(0)
  #define KRD(G,j) do{ if(G){ kload2(kf,kp0+sl_next,j); SBAR(); } }while(0)
  #define STEP(C0,C1,P0,P1,t,GK,GV,GL) do{ SBAR(); \
    const lds_cptr vp_=vp0+sl_prev; \
    VRD(0); SBAR(); float sacc=(P0[0]+P0[1]); \
    GAPA(C0=__builtin_amdgcn_mfma_f32_32x32x16_bf16(kf[0],qr[0],C0,0,0,0), P0[2],P0[3],P0[4],P0[5],     pw0[0]=PKW(P0,0), pw0[1]=PKW(P0,2), pw0); \
    VRD(4); SBAR(); GAPA(C1=__builtin_amdgcn_mfma_f32_32x32x16_bf16(kf[1],qr[0],C1,0,0,0), P0[6],P0[7],P0[8],P0[9],     pw0[2]=PKW(P0,4), pw0[3]=PKW(P0,6), pw0); \
    VRD(1); SBAR(); GAPA(C0=__builtin_amdgcn_mfma_f32_32x32x16_bf16(kf[2],qr[1],C0,0,0,0),   P0[10],P0[11],P0[12],P0[13], pw1[0]=PKW(P0,8), pw1[1]=PKW(P0,10), pw1); \
    VRD(5); SBAR(); GAPA(C1=__builtin_amdgcn_mfma_f32_32x32x16_bf16(kf[3],qr[1],C1,0,0,0),   P0[14],P0[15],P1[0],P1[1],   pw1[2]=PKW(P0,12),pw1[3]=PKW(P0,14), pw1); \
    VRD(2); SBAR(); GAPA(C0=__builtin_amdgcn_mfma_f32_32x32x16_bf16(kf[4],qr[2],C0,0,0,0),   P1[2],P1[3],P1[4],P1[5],     pw2[0]=PKW(P1,0), pw2[1]=PKW(P1,2), pw2); \
    VRD(6); SBAR(); GAPA(C1=__builtin_amdgcn_mfma_f32_32x32x16_bf16(kf[5],qr[2],C1,0,0,0),   P1[6],P1[7],P1[8],P1[9],     pw2[2]=PKW(P1,4), pw2[3]=PKW(P1,6), pw2); \
    VRD(3); SBAR(); GAPA(C0=__builtin_amdgcn_mfma_f32_32x32x16_bf16(kf[6],qr[3],C0,0,0,0),   P1[10],P1[11],P1[12],P1[13], pw3[0]=PKW(P1,8), pw3[1]=PKW(P1,10), pw3); \
    VRD(7); SBAR(); GAPA(C1=__builtin_amdgcn_mfma_f32_32x32x16_bf16(kf[7],qr[3],C1,0,0,0),   P1[14],P1[15],0.f,0.f,       pw3[2]=PKW(P1,12),pw3[3]=PKW(P1,14), pw3); \
    l_reg+=sacc; \
    if(GK){DMA_K((t)+3,sl_cur);} if(GV){DMA_V((t)+1,sl_next);} \
    CMASK(C0,C1,t); \
    { float a=MX3(C0[0],C0[1],C1[0]),b=MX3(C0[2],C0[3],C1[1]); a=MX3(a,C1[2],C1[3]); \
      _Pragma("unroll") for(int r=4;r<16;r+=4){a=MX3(a,C0[r],C0[r+1]);b=MX3(b,C0[r+2],C0[r+3]);a=MX3(a,C1[r],C1[r+1]);b=MX3(b,C1[r+2],C1[r+3]);} \
      float rm=__builtin_fmaxf(a,b); { auto rr=__builtin_amdgcn_permlane32_swap(__float_as_uint(rm),__float_as_uint(rm),false,false); rm=__builtin_fmaxf(__uint_as_float(rr[0]),__uint_as_float(rr[1])); } \
      resc=false; \
      if(__builtin_expect(__any(rm>(float)THRL),0)){ const float dl=__builtin_fmaxf(rm,0.f); mhat+=dl; \
        _Pragma("unroll") for(int r=0;r<16;++r){C0[r]-=dl;C1[r]-=dl;} \
        nbase-=dl; \
        const float f=__builtin_amdgcn_exp2f(-dl); l_reg*=f; if(hi==0)wsf[r32]=f; resc=true; } } \
    SBAR(); \
    GAPB(o[0]=__builtin_amdgcn_mfma_f32_32x32x16_bf16(PAF(0),VFR(0),o[0],0,0,0), C0,0); \
    GAPB(o[1]=__builtin_amdgcn_mfma_f32_32x32x16_bf16(PAF(0),VFR(4),o[1],0,0,0), C0,4); \
    KRD(GL,0); GAPB(o[0]=__builtin_amdgcn_mfma_f32_32x32x16_bf16(PAF(1),VFR(1),o[0],0,0,0), C0,8); \
    KRD(GL,1); GAPB(o[1]=__builtin_amdgcn_mfma_f32_32x32x16_bf16(PAF(1),VFR(5),o[1],0,0,0), C0,12); \
    KRD(GL,2); GAPB(o[0]=__builtin_amdgcn_mfma_f32_32x32x16_bf16(PAF(2),VFR(2),o[0],0,0,0), C1,0); \
    KRD(GL,3); GAPB(o[1]=__builtin_amdgcn_mfma_f32_32x32x16_bf16(PAF(2),VFR(6),o[1],0,0,0), C1,4); \
    GAPB(o[0]=__builtin_amdgcn_mfma_f32_32x32x16_bf16(PAF(3),VFR(3),o[0],0,0,0), C1,8); \
    GAPB(o[1]=__builtin_amdgcn_mfma_f32_32x32x16_bf16(PAF(3),VFR(7),o[1],0,0,0), C1,12); \
    if(GV){ BIASFILL(P0,P1,(t)+1); } \
    }while(0)
  int t=1;
  #undef CMASK
  #define CMASK(P0,P1,t) do{}while(0)
  for(;t+5<NT;t+=2){
    STEP(pB0,pB1,pA0,pA1,t,true,true,true);     WAIT_BAR(2); RESC(); ROT();
    STEP(pA0,pA1,pB0,pB1,t+1,true,true,true);   WAIT_BAR(2); RESC(); ROT();
  }
  #undef CMASK
  #define CMASK(P0,P1,t) do{int jb_=(t)-(NT-4); if(jb_>=0)cmask(P0,P1,jb_,qrel,hi);}while(0)
  #define ENDW(tt) do{ if((tt)+3<NT){WAIT_BAR(2);} else if((tt)+2<NT){WAIT_BAR(1);} else {WAIT_BAR(0);} }while(0)
  for(;t+1<NT;t+=2){
    STEP(pB0,pB1,pA0,pA1,t,(t+3<NT),(t+1<NT),(t+1<NT));       ENDW(t);   RESC(); ROT();
    STEP(pA0,pA1,pB0,pB1,t+1,(t+4<NT),(t+2<NT),(t+2<NT));     ENDW(t+1); RESC(); ROT();
  }
  STEP(pB0,pB1,pA0,pA1,NT-1,false,false,false); RESC();
  { float sacc=pB0[0]+pB0[1]; _Pragma("unroll") for(int r=2;r<16;++r)sacc+=pB0[r]; _Pragma("unroll") for(int r=0;r<16;++r)sacc+=pB1[r]; l_reg+=sacc;
    pw0=(u32x4){PKW(pB0,0),PKW(pB0,2),PKW(pB0,4),PKW(pB0,6)};pw1=(u32x4){PKW(pB0,8),PKW(pB0,10),PKW(pB0,12),PKW(pB0,14)};pw2=(u32x4){PKW(pB1,0),PKW(pB1,2),PKW(pB1,4),PKW(pB1,6)};pw3=(u32x4){PKW(pB1,8),PKW(pB1,10),PKW(pB1,12),PKW(pB1,14)};
    SBAR(); pv(o,vb0+sl_cur,PAF(0),PAF(1),PAF(2),PAF(3)); }
  #undef PKW
  #undef PAF
  #undef VFR
  #undef PIN
  #undef MX3
  #undef GAPA
  #undef GAPB
  #undef EX
  #undef VRD
  #undef KRD
  #undef STEP
  #undef ENDW
  {auto rr=__builtin_amdgcn_permlane32_swap(__float_as_uint(l_reg),__float_as_uint(l_reg),false,false);l_reg=__uint_as_float(rr[0])+__uint_as_float(rr[1]);}
  if(hi==0)wsf[32+r32]=l_reg;asm volatile("s_waitcnt lgkmcnt(0)":::"memory");
  float rli[16];
  #pragma unroll
  for(int r=0;r<16;++r)rli[r]=__builtin_amdgcn_rcpf(wsf[32+crow(r,hi)]);
  bf16*Ow=O+(rowbase+q0+wid*QBLK)*DM+h*D;
  { bf16*stg=(bf16*)(shm+LDS_OST)+wid*2048;
    #pragma unroll
    for(int r=0;r<16;++r){const int orow=crow(r,hi);
      #pragma unroll
      for(int d0=0;d0<2;++d0)stg[orow*64+d0*32+r32]=__float2bfloat16(o[d0][r]*rli[r]);}
    asm volatile("s_waitcnt lgkmcnt(0)":::"memory");
    #pragma unroll
    for(int i=0;i<4;++i){const int row=i*8+(lane>>3),ch=lane&7; const u32x4 v=*(const u32x4*)(stg+row*64+ch*8); ATTN_STORE16(Ow+(long)row*DM+ch*8,v);} }
  asm volatile("s_waitcnt lgkmcnt(0)\n\ts_barrier":::"memory");
  #undef BIASFILL
  #undef DMA_K
  #undef DMA_V
  #undef CMASK
  #undef START
  #undef RESC
  #undef ROT
}
constexpr int ATTN_LDS_BYTES=LDS_BYTES;
struct AttnTensors { const bf16* Q; const bf16* K; const bf16* V; bf16* O; };
struct AttnUnit { int bh; int qb; };
struct StaticOrder {
  int vcu;
  __device__ __forceinline__ explicit StaticOrder(int grid,int block):vcu((block%8)*(grid/8)+block/8){}
  __device__ __forceinline__ bool next(int i,AttnUnit&u)const{ if(i>=4)return false; const int s=2*(vcu&1); u.bh=vcu>>1; u.qb=(i==0)?s:(i==1)?7-s:(i==2)?s+1:6-s; return true; }
  __device__ __forceinline__ void a_ready(const AttnUnit&)const{}
  __device__ __forceinline__ void done(const AttnUnit&)const{}
};
template<class Sched,int THRL=8> __device__ __forceinline__ void attn_phase(char*lds,const AttnTensors&T,const Sched&S,int csl_off){
  AttnUnit u;
  for(int i=0;S.next(i,u);++i){ S.a_ready(u); attn_unit<THRL>(u.bh/NHEAD,u.bh%NHEAD,u.qb,T.Q,T.K,T.V,T.O,lds,csl_off); S.done(u); }
}
#undef SBAR
#undef WAIT_BAR
}

#define GAS __attribute__((address_space(1)))
#define LAS __attribute__((address_space(3)))
typedef unsigned v4u __attribute__((ext_vector_type(4)));
typedef GAS unsigned gu32;
typedef GAS unsigned long long gu64;
#define RLX_AGENT __ATOMIC_RELAXED, __HIP_MEMORY_SCOPE_AGENT
#define LDS_WAIT() asm volatile("s_waitcnt lgkmcnt(0)" ::: "memory")
#define VM_WAIT() asm volatile("s_waitcnt vmcnt(0)" ::: "memory")
__device__ __forceinline__ unsigned long long rt() { return __builtin_amdgcn_s_memrealtime(); }

#define XB_TMO      128
#define XB_XCNT(j)  (256  + 64 * (j))
#define XB_XSUB(j)  (1280 + 64 * (j))
#define XB_XGEN(j)  (2304 + 64 * (j))
#define XB_TOP      3328
#define XB_TOPGEN   3392
#define XCD_BAR_WORDS 3456
#define XB_SPIN_CAP (1u << 18)

__device__ __forceinline__ unsigned xb_ld(unsigned* p)              { return __hip_atomic_load(p, __ATOMIC_RELAXED, __HIP_MEMORY_SCOPE_AGENT); }
__device__ __forceinline__ unsigned xb_add(unsigned* p, unsigned v) { return __hip_atomic_fetch_add(p, v, __ATOMIC_RELAXED, __HIP_MEMORY_SCOPE_AGENT); }
__device__ __forceinline__ unsigned xb_xcc_id() { return (unsigned)__builtin_amdgcn_s_getreg((3 << 11) | 20) & 0xFu; }
#define XB_SPIN(cond, bar) do { unsigned _sp = 0; while (cond) { __builtin_amdgcn_s_sleep(1); \
    if ((++_sp & 255u) == 0u) { if (xb_ld(&(bar)[XB_TMO])) break; if (_sp > XB_SPIN_CAP) { atomicAdd(&(bar)[XB_TMO], 1u); break; } } } } while (0)

struct XcdBarrier {
    unsigned* bar; unsigned x;
    volatile LAS unsigned* st;
};

__device__ __forceinline__ XcdBarrier xcd_barrier_post(unsigned* bar, volatile LAS unsigned* st) {
    XcdBarrier b; b.bar = bar; b.x = xb_xcc_id(); b.st = st;
    if (threadIdx.x == 0) (void)xb_add(&bar[XB_XCNT(b.x)], 1u);
    return b;
}
__device__ __forceinline__ void xcd_barrier_complete(unsigned* bar, unsigned x, unsigned& nloc, unsigned& nx) {
    const unsigned G = gridDim.x * gridDim.y * gridDim.z;
    unsigned sum, cnt, mine, sp = 0u;
    for (;;) {
        sum = 0u; cnt = 0u; mine = 0u;
#pragma unroll
        for (unsigned j = 0; j < 16; ++j) { const unsigned c = xb_ld(&bar[XB_XCNT(j)]); sum += c; cnt += (c > 0u) ? 1u : 0u; mine = (j == x) ? c : mine; }
        if (sum == G) break;
        __builtin_amdgcn_s_sleep(1);
        if ((++sp & 255u) == 0u) { if (xb_ld(&bar[XB_TMO])) break; if (sp > XB_SPIN_CAP) { atomicAdd(&bar[XB_TMO], 1u); break; } }
    }
    nloc = mine > 0u ? mine : 1u; nx = cnt > 0u ? cnt : 1u;
}

__device__ __forceinline__ void xcd_barrier(const XcdBarrier& b) {
    asm volatile("s_waitcnt vmcnt(0)" ::: "memory");
    __syncthreads();
    if (threadIdx.x == 0) {
        unsigned* bar = b.bar;
        __builtin_amdgcn_s_waitcnt(0);
        unsigned nloc = b.st[0], nx = b.st[1];
        if (nloc == 0u) { xcd_barrier_complete(bar, b.x, nloc, nx); b.st[0] = nloc; b.st[1] = nx; }
        const unsigned old = xb_add(&bar[XB_XSUB(b.x)], 1u);
        const unsigned gen = old / nloc;
        if (old + 1u == (gen + 1u) * nloc) {
            __builtin_amdgcn_fence(__ATOMIC_RELEASE, "agent");
            asm volatile("s_waitcnt vmcnt(0)" ::: "memory");
            const unsigned og = xb_add(&bar[XB_TOP], 1u);
            const unsigned tg = og / nx;
            if (og + 1u == (tg + 1u) * nx) xb_add(&bar[XB_TOPGEN], 1u);
            else XB_SPIN(xb_ld(&bar[XB_TOPGEN]) == tg, bar);
            __builtin_amdgcn_fence(__ATOMIC_ACQUIRE, "agent");
            xb_add(&bar[XB_XGEN(b.x)], 1u);
            asm volatile("s_waitcnt vmcnt(0)" ::: "memory");
        } else {
            XB_SPIN(xb_ld(&bar[XB_XGEN(b.x)]) == gen, bar);
            __builtin_amdgcn_fence(__ATOMIC_ACQUIRE, "agent");
            asm volatile("s_waitcnt vmcnt(0)" ::: "memory");
        }
    }
    __syncthreads();
}

constexpr int NWAVES = 8;
constexpr int RING_OFF = 0, RING_BYTES = 131072;
constexpr int LDS_CSL = 86016;
constexpr int LDSCTL_OFF = RING_BYTES, MISC_OFF = LDSCTL_OFF + 320;
constexpr int LDS_BYTES = 147456;
static_assert(attn_body::ATTN_LDS_BYTES <= LDS_CSL && LDS_CSL + NKEY * 4 <= RING_BYTES, "LDS map");
constexpr int CW_BAR = 1024;
constexpr size_t CTL_ZERO_BYTES = 65536;
static_assert((CW_BAR + XCD_BAR_WORDS) * 4 <= (int)CTL_ZERO_BYTES, "ctl");

template <class F> struct EpiElem {
    static constexpr bool PERM = false, AFTER_DRAIN = false; F f;
    __device__ __forceinline__ void operator()(const f32x4 (&acc)[2][2][4][2], const pg8::Unit& u, int wr, int wc, int fr, int fq) const {
        const int row0 = u.pm * 256 + wr * 64 + fr, col0 = u.pn * 256 + wc * 32 + 4 * fq;
#pragma unroll
        for (int ai = 0; ai < 2; ++ai)
#pragma unroll
            for (int m = 0; m < 4; ++m)
#pragma unroll
                for (int bj = 0; bj < 2; ++bj)
#pragma unroll
                    for (int n = 0; n < 2; ++n) f(row0 + ai * 128 + m * 16, col0 + bj * 128 + n * 16, acc[ai][bj][m][n]);
    }
};

template <int PER, class Ld> __device__ __forceinline__ void block_cumsum_lds(float* csl, float* wtot, int npos, const Ld& ld) {
    const int tid = threadIdx.x, lane = tid & 63, wave = tid >> 6;
    float v[PER]; float run = 0.f;
#pragma unroll
    for (int e = 0; e < PER; ++e) { const int pos = tid * PER + e; v[e] = pos < npos ? ld(pos) : 0.f; run += v[e]; v[e] = run; }
    const float incl = wave_incl_scan(run, lane), excl = incl - run;
    if (lane == 63) wtot[wave] = incl;
    __syncthreads();
    float off = excl;
#pragma unroll
    for (int w = 0; w < 8; ++w) if (w < wave) off += wtot[w];
#pragma unroll
    for (int e = 0; e < PER; ++e) { const int pos = tid * PER + e; if (pos < npos) csl[pos] = (off + v[e]) * LOG2E; }
    __syncthreads();
}

__device__ __forceinline__ void pool_seg16(const Params& p, int row0, int ch) {
    const bf16_t* U = (const bf16_t*)(p.ws + WS_U); bf16_t* PO = (bf16_t*)(p.ws + WS_PO);
    const int c0 = ch * 8, g = c0 >> 8, w = 2 << g, t0 = row0 % SEQ;
    float s[8];
#pragma unroll
    for (int e = 0; e < 8; ++e) s[e] = 0.f;
    for (int j = 1; j < w; ++j) if (t0 - j >= 0) { const u32x4 v = *(const u32x4*)(U + (size_t)(row0 - j) * PW + c0);
        s[0] += bflo(v.x); s[1] += bfhi(v.x); s[2] += bflo(v.y); s[3] += bfhi(v.y); s[4] += bflo(v.z); s[5] += bfhi(v.z); s[6] += bflo(v.w); s[7] += bfhi(v.w); }
#pragma unroll 4
    for (int r = 0; r < 16; ++r) { const int t = t0 + r; const u32x4 v = *(const u32x4*)(U + (size_t)(row0 + r) * PW + c0);
        const float cur[8] = {bflo(v.x), bfhi(v.x), bflo(v.y), bfhi(v.y), bflo(v.z), bfhi(v.z), bflo(v.w), bfhi(v.w)};
        const float cnt = (float)((t + 1 < w) ? t + 1 : w); float o[8];
#pragma unroll
        for (int e = 0; e < 8; ++e) { s[e] += cur[e]; o[e] = s[e] / cnt - cur[e]; }
        u32x4 ov; ov.x = pk2(o[0], o[1]); ov.y = pk2(o[2], o[3]); ov.z = pk2(o[4], o[5]); ov.w = pk2(o[6], o[7]);
        *(u32x4*)(PO + (size_t)(row0 + r) * PW + c0) = ov;
        if (t - w + 1 >= 0) { const u32x4 q = *(const u32x4*)(U + (size_t)(row0 + r - w + 1) * PW + c0);
            s[0] -= bflo(q.x); s[1] -= bfhi(q.x); s[2] -= bflo(q.y); s[3] -= bfhi(q.y); s[4] -= bflo(q.z); s[5] -= bfhi(q.z); s[6] -= bflo(q.w); s[7] -= bfhi(q.w); } }
}

__device__ __forceinline__ void sample_attn(const Params& p, int bh, const float* csl, float* part) {
    const int tid = threadIdx.x, lane = tid & 63, wave = tid >> 6, i = lane & 15, dq = lane >> 4, b = bh / NH, h = bh % NH;
    const bf16_t* Q = (const bf16_t*)(p.ws + WS_Q); const bf16_t* Kb = (const bf16_t*)(p.ws + WS_K); const bf16_t* Vb = (const bf16_t*)(p.ws + WS_V);
    const int qrow = MP + b * SN + i;
    float q[16], o[16];
    { const u32x4* qp = (const u32x4*)(Q + (size_t)qrow * AW + h * DH + dq * 16);
#pragma unroll
      for (int e = 0; e < 2; ++e) { const u32x4 w = qp[e]; q[8 * e] = bflo(w.x); q[8 * e + 1] = bfhi(w.x); q[8 * e + 2] = bflo(w.y); q[8 * e + 3] = bfhi(w.y); q[8 * e + 4] = bflo(w.z); q[8 * e + 5] = bfhi(w.z); q[8 * e + 6] = bflo(w.w); q[8 * e + 7] = bfhi(w.w); } }
#pragma unroll
    for (int d = 0; d < 16; ++d) o[d] = 0.f;
    const float ct = csl[PAST + i]; float m = -INFINITY, l = 0.f;
    const int s0 = wave * 258;
#pragma unroll 2
    for (int s = s0; s < s0 + 258; ++s) {
        float kk[16], vv[16];
        if (s < PAST) { const f32x4* kp = (const f32x4*)(p.ck + (((size_t)b * PAST + s) * NH + h) * DH + dq * 16); const f32x4* vp = (const f32x4*)(p.cv + (((size_t)b * PAST + s) * NH + h) * DH + dq * 16);
#pragma unroll
            for (int e = 0; e < 4; ++e) { const f32x4 a = kp[e], c = vp[e]; kk[4 * e] = a.x; kk[4 * e + 1] = a.y; kk[4 * e + 2] = a.z; kk[4 * e + 3] = a.w; vv[4 * e] = c.x; vv[4 * e + 1] = c.y; vv[4 * e + 2] = c.z; vv[4 * e + 3] = c.w; }
        } else { const int r2 = MP + b * SN + (s - PAST); const u32x4* kp = (const u32x4*)(Kb + (size_t)r2 * AW + h * DH + dq * 16); const u32x4* vp = (const u32x4*)(Vb + (size_t)r2 * AW + h * DH + dq * 16);
#pragma unroll
            for (int e = 0; e < 2; ++e) { const u32x4 a = kp[e], c = vp[e];
                kk[8 * e] = bflo(a.x); kk[8 * e + 1] = bfhi(a.x); kk[8 * e + 2] = bflo(a.y); kk[8 * e + 3] = bfhi(a.y); kk[8 * e + 4] = bflo(a.z); kk[8 * e + 5] = bfhi(a.z); kk[8 * e + 6] = bflo(a.w); kk[8 * e + 7] = bfhi(a.w);
                vv[8 * e] = bflo(c.x); vv[8 * e + 1] = bfhi(c.x); vv[8 * e + 2] = bflo(c.y); vv[8 * e + 3] = bfhi(c.y); vv[8 * e + 4] = bflo(c.z); vv[8 * e + 5] = bfhi(c.z); vv[8 * e + 6] = bflo(c.w); vv[8 * e + 7] = bfhi(c.w); }
        }
        float dot = 0.f;
#pragma unroll
        for (int d = 0; d < 16; ++d) dot += q[d] * kk[d];
        dot += __shfl_xor(dot, 16); dot += __shfl_xor(dot, 32);
        const bool ok = (s < PAST) || (s - PAST <= i);
        const float sc = ok ? dot + ct - csl[s] : -INFINITY;
        const float mn = fmaxf(m, sc), alpha = exp2f(m - mn), pe = exp2f(sc - mn);
        l = l * alpha + pe; m = mn;
#pragma unroll
        for (int d = 0; d < 16; ++d) o[d] = o[d] * alpha + pe * vv[d];
    }
    float* my = part + (wave * 16 + i) * 66;
#pragma unroll
    for (int d = 0; d < 16; ++d) my[dq * 16 + d] = o[d];
    if (dq == 0) { my[64] = m; my[65] = l; }
    __syncthreads();
    { const int i2 = tid & 15, dg = tid >> 4;
        float M = -INFINITY;
#pragma unroll
        for (int w = 0; w < 8; ++w) M = fmaxf(M, part[(w * 16 + i2) * 66 + 64]);
        float L = 0.f, a0 = 0.f, a1 = 0.f;
#pragma unroll
        for (int w = 0; w < 8; ++w) { const float* pw_ = part + (w * 16 + i2) * 66; const float f = exp2f(pw_[64] - M); L += f * pw_[65]; a0 += f * pw_[2 * dg]; a1 += f * pw_[2 * dg + 1]; }
        const float rl = 1.f / L;
        *(unsigned*)((bf16_t*)(p.ws + WS_Q) + (size_t)(MP + b * SN + i2) * AW + h * DH + 2 * dg) = pk2(a0 * rl, a1 * rl);
    }
    __syncthreads();
}

__global__ void __launch_bounds__(NWAVES * 64, 2) mega_fwd(Params p) {
    extern __shared__ __attribute__((aligned(16))) unsigned char lds[];
    LAS unsigned char* ldsl = (LAS unsigned char*)lds;
    volatile LAS unsigned* MISC = (volatile LAS unsigned*)(ldsl + MISC_OFF);
    const int tid = threadIdx.x, lane = tid & 63, wave = __builtin_amdgcn_readfirstlane(tid >> 6);
    const int G = gridDim.x, bx = blockIdx.x, vcu = (G % 8 == 0) ? (bx % 8) * (G / 8) + bx / 8 : bx;
    gu32* ctl = (gu32*)(p.ws + WS_CTL);
    for (int u = tid; u < (LDS_BYTES - LDSCTL_OFF) / 4; u += NWAVES * 64) ((LAS unsigned*)(ldsl + LDSCTL_OFF))[u] = 0u;
    __syncthreads();
    const bool one = (p.ph_hi - p.ph_lo) > 1;
    XcdBarrier bar; bar.bar = (unsigned*)(ctl + CW_BAR); bar.x = 0; bar.st = nullptr;
    if (one) bar = xcd_barrier_post((unsigned*)(ctl + CW_BAR), MISC + 8);
    const int lo = p.ph_lo, hi = p.ph_hi;
#define IN(k) (lo <= (k) && (k) < hi)
#define SEAM(k) do { if (IN(k) && IN((k) + 1)) xcd_barrier(bar); } while (0)
    const int gw = vcu * NWAVES + wave, NGW = G * NWAVES;
    bf16_t* H = (bf16_t*)(p.ws + WS_H);

    if (IN(0)) {
        convert_weights(p, (float*)(lds + wave * 16384), gw, NGW, lane);
        for (int row = gw; row < R; row += NGW) rms_row_to_bf16(xrow(p, row), p.g_pre, H + (size_t)row * D, lane);
    }
    SEAM(0);
    if (IN(1)) {
        pg8::Gemm g{H, (const bf16_t*)(p.ws + WS_WIN), R, NMAIN, D, D, 0}; pg8::StaticOrder S; S.init(R, NMAIN, G, bx);
        EpiElem<EpiIn> E{EpiIn{(bf16_t*)(p.ws + WS_Q), (bf16_t*)(p.ws + WS_K), (bf16_t*)(p.ws + WS_V), (bf16_t*)(p.ws + WS_U), (bf16_t*)(p.ws + WS_SA), (bf16_t*)(p.ws + WS_SB), p.out, p.pscale}};
        pg8::gemm_phase<EpiElem<EpiIn>, pg8::StaticOrder, true, true>(ldsl + RING_OFF, g, S, E);
        __syncthreads();
        for (int t = bx; t < R / 128; t += G) {
            EpiLogf EL{(float*)(p.ws + WS_LOGF), p.out, p.b_f};
            sgemm_tile<8, 1, 1, 1>(lds, H, D, (const bf16_t*)(p.ws + WS_WIN) + (size_t)NMAIN * D, D, D, t * 128, 0, EL);
            __syncthreads();
        }
    }
    SEAM(1);
    if (IN(2)) {
        float* csl = (float*)(lds + LDS_CSL); float* wtot = (float*)(lds + LDS_CSL + 8320);
        const float* LOGF = (const float*)(p.ws + WS_LOGF);
        const attn_body::StaticOrder S(G, bx);
        { const int bh = S.vcu >> 1, b = bh / NH, h = bh % NH;
          block_cumsum_lds<4>(csl, wtot, SEQ, [&](int pos) { return LOGF[((size_t)b * SEQ + pos) * NH + h]; }); }
        const attn_body::AttnTensors AT{(const attn_body::bf16*)(p.ws + WS_Q), (const attn_body::bf16*)(p.ws + WS_K), (const attn_body::bf16*)(p.ws + WS_V), (attn_body::bf16*)(p.ws + WS_Q)};
        attn_body::attn_phase<attn_body::StaticOrder>((char*)lds + RING_OFF, AT, S, LDS_CSL);
        { const int gt = bx * (NWAVES * 64) + tid; for (int it = gt; it < (MP / 16) * (PW / 8); it += G * NWAVES * 64) pool_seg16(p, (it / (PW / 8)) * 16, it % (PW / 8));
          for (int it = gt; it < MS * (PW / 8); it += G * NWAVES * 64) pool_chunk(p, MP + it / (PW / 8), it % (PW / 8)); }
        for (int bh = bx; bh < SB_ * NH; bh += G) { const int b = bh / NH, h = bh % NH;
            __syncthreads();
            block_cumsum_lds<5>(csl, wtot, NKEY, [&](int pos) { return pos < PAST ? p.clf[((size_t)b * PAST + pos) * NH + h] : LOGF[((size_t)MP + b * SN + (pos - PAST)) * NH + h]; });
            sample_attn(p, bh, csl, (float*)lds); }
    }
    SEAM(2);
    if (IN(3)) {
        { int kpool = 256; asm volatile("" : "+s"(kpool));
          pg8::Gemm g{(const bf16_t*)(p.ws + WS_PO), (const bf16_t*)(p.ws + WS_WPOOL), R, D, kpool, PW, 256}; pg8::StaticOrder S; S.init(R, D, G, bx);
          EpiElem<EpiPool> E{EpiPool{(const bf16_t*)(p.ws + WS_SB), (bf16_t*)(p.ws + WS_TM)}};
          pg8::gemm_phase<EpiElem<EpiPool>, pg8::StaticOrder, true, true>(ldsl + RING_OFF, g, S, E); }
        __syncthreads();
        { pg8::Gemm g{(const bf16_t*)(p.ws + WS_Q), (const bf16_t*)(p.ws + WS_WUP), R, D, AW, AW, 0}; pg8::StaticOrder S; S.init(R, D, G, bx);
          EpiElem<EpiUp> E{EpiUp{(const bf16_t*)(p.ws + WS_SA), (bf16_t*)(p.ws + WS_TM)}};
          pg8::gemm_phase<EpiElem<EpiUp>, pg8::StaticOrder, true, true>(ldsl + RING_OFF, g, S, E); }
    }
    SEAM(3);
    if (IN(4)) {
        pg8::Gemm g{(const bf16_t*)(p.ws + WS_TM), (const bf16_t*)(p.ws + WS_WOUT), R, D, D, D, 0}; pg8::StaticOrder S; S.init(R, D, G, bx);
        EpiElem<EpiF32> E{EpiF32{(float*)(p.ws + WS_MO), D}};
        pg8::gemm_phase<EpiElem<EpiF32>, pg8::StaticOrder, true, true>(ldsl + RING_OFF, g, S, E);
    }
    SEAM(4);
    if (IN(5)) {
        const float* MO = (const float*)(p.ws + WS_MO);
        for (int row = gw; row < R; row += NGW) {
            const f32x4* mr = (const f32x4*)(MO + (size_t)row * D) + lane; const f32x4* xr = (const f32x4*)xrow(p, row) + lane;
            const f32x4* g1 = (const f32x4*)p.g_post + lane; const f32x4* g2 = (const f32x4*)p.g_ffn_pre + lane;
            f32x4 v[8]; float s = 0.f;
#pragma unroll
            for (int j = 0; j < 8; ++j) { v[j] = mr[64 * j]; s += (v[j].x * v[j].x + v[j].y * v[j].y) + (v[j].z * v[j].z + v[j].w * v[j].w); }
            const float r1 = rsqrtf(wave_sum(s) * (1.f / D) + EPS); float s2 = 0.f;
            f32x4* orow = (f32x4*)(p.out + O_Y + (size_t)row * D) + lane;
#pragma unroll
            for (int j = 0; j < 8; ++j) { v[j] = xr[64 * j] + v[j] * r1 * g1[64 * j]; orow[64 * j] = v[j]; s2 += (v[j].x * v[j].x + v[j].y * v[j].y) + (v[j].z * v[j].z + v[j].w * v[j].w); }
            const float r2 = rsqrtf(wave_sum(s2) * (1.f / D) + EPS);
            u32x2* o8 = (u32x2*)(H + (size_t)row * D) + lane;
#pragma unroll
            for (int j = 0; j < 8; ++j) { const f32x4 gg = g2[64 * j]; u32x2 w; w.x = pk2(v[j].x * r2 * gg.x, v[j].y * r2 * gg.y); w.y = pk2(v[j].z * r2 * gg.z, v[j].w * r2 * gg.w); o8[64 * j] = w; }
        }
    }
    SEAM(5);
    if (IN(6)) {
        pg8::Gemm g{H, (const bf16_t*)(p.ws + WS_WFF1), R, FF, D, D, 0}; pg8::StaticOrder S; S.init(R, FF, G, bx);
        EpiElem<EpiRelu2> E{EpiRelu2{(bf16_t*)(p.ws + WS_Z)}};
        pg8::gemm_phase<EpiElem<EpiRelu2>, pg8::StaticOrder, true, true>(ldsl + RING_OFF, g, S, E);
    }
    SEAM(6);
    if (IN(7)) {
        pg8::Gemm g{(const bf16_t*)(p.ws + WS_Z), (const bf16_t*)(p.ws + WS_WFF2), R, D, FF, FF, 0}; pg8::StaticOrder S; S.init(R, D, G, bx);
        EpiElem<EpiF32> E{EpiF32{(float*)(p.ws + WS_FO), D}};
        pg8::gemm_phase<EpiElem<EpiF32>, pg8::StaticOrder, true, true>(ldsl + RING_OFF, g, S, E);
    }
    SEAM(7);
    if (IN(8)) {
        const float* FO = (const float*)(p.ws + WS_FO);
        for (int row = gw; row < R; row += NGW) {
            const f32x4* fr = (const f32x4*)(FO + (size_t)row * D) + lane; const f32x4* g3 = (const f32x4*)p.g_ffn_post + lane;
            f32x4 v[8]; float s = 0.f;
#pragma unroll
            for (int j = 0; j < 8; ++j) { v[j] = fr[64 * j]; s += (v[j].x * v[j].x + v[j].y * v[j].y) + (v[j].z * v[j].z + v[j].w * v[j].w); }
            const float r1 = rsqrtf(wave_sum(s) * (1.f / D) + EPS);
            f32x4* orow = (f32x4*)(p.out + O_Y + (size_t)row * D) + lane;
#pragma unroll
            for (int j = 0; j < 8; ++j) orow[64 * j] = orow[64 * j] + v[j] * r1 * g3[64 * j];
        }
    }
#undef IN
#undef SEAM
}

#ifndef MK_SPLIT
#define MK_SPLIT 0
#endif
constexpr int NPHASE = 9;
extern "C" void kernel_launch(void* const* d_in, const int* in_sizes, int n_in, void* d_out, int out_size, void* d_ws, size_t ws_size, hipStream_t stream) {
    static int grid = 0;
    if (grid == 0) {
        if (n_in != 18 || (size_t)out_size != O_END || ws_size < WS_END) { fprintf(stderr, "kernel_launch: unexpected sizes n_in %d out %d ws %zu\n", n_in, out_size, ws_size); grid = -1; return; }
        int dev = 0, cus = 0, per_cu = 0;
        if (hipGetDevice(&dev) != hipSuccess || hipDeviceGetAttribute(&cus, hipDeviceAttributeMultiprocessorCount, dev) != hipSuccess) { grid = -1; return; }
        if (hipFuncSetAttribute((const void*)mega_fwd, hipFuncAttributeMaxDynamicSharedMemorySize, LDS_BYTES) != hipSuccess) { fprintf(stderr, "kernel_launch: hipFuncSetAttribute failed\n"); grid = -1; return; }
        if (hipOccupancyMaxActiveBlocksPerMultiprocessor(&per_cu, (const void*)mega_fwd, NWAVES * 64, LDS_BYTES) != hipSuccess || per_cu < 1) { fprintf(stderr, "kernel_launch: occupancy query says %d blocks per CU\n", per_cu); (void)hipGetLastError(); grid = -1; return; }
        grid = cus;
        if (grid > 256) grid = 256;
        grid &= ~7;
    }
    if (grid <= 0) return;
    (void)hipMemsetAsync((char*)d_ws + WS_CTL, 0, CTL_ZERO_BYTES, stream);
    Params p{};
    p.xp = (const float*)d_in[0]; p.xs = (const float*)d_in[1]; p.ck = (const float*)d_in[2]; p.cv = (const float*)d_in[3]; p.clf = (const float*)d_in[4]; p.sp = (const float*)d_in[5];
    p.g_pre = (const float*)d_in[6]; p.w_in = (const float*)d_in[7]; p.b_f = (const float*)d_in[8]; p.w_up = (const float*)d_in[9]; p.w_pool = (const float*)d_in[10]; p.pscale = (const float*)d_in[11];
    p.w_out = (const float*)d_in[12]; p.g_post = (const float*)d_in[13]; p.g_ffn_pre = (const float*)d_in[14]; p.w_ff1 = (const float*)d_in[15]; p.w_ff2 = (const float*)d_in[16]; p.g_ffn_post = (const float*)d_in[17];
    p.out = (float*)d_out; p.ws = (unsigned char*)d_ws;
#if MK_SPLIT
    for (int k = 0; k < NPHASE; ++k) { p.ph_lo = k; p.ph_hi = k + 1; hipLaunchKernelGGL(mega_fwd, dim3(grid), dim3(NWAVES * 64), LDS_BYTES, stream, p); }
#else
    p.ph_lo = 0; p.ph_hi = NPHASE;
    hipLaunchKernelGGL(mega_fwd, dim3(grid), dim3(NWAVES * 64), LDS_BYTES, stream, p);
#endif
}
```

```cpp
#include <hip/hip_runtime.h>
#include <stdint.h>
#include <stdio.h>

typedef unsigned short bf16_t;
typedef short bf16x8 __attribute__((ext_vector_type(8)));
typedef float f32x4 __attribute__((ext_vector_type(4)));
typedef float f32x2 __attribute__((ext_vector_type(2)));
typedef unsigned u32x4 __attribute__((ext_vector_type(4)));
typedef unsigned u32x2 __attribute__((ext_vector_type(2)));

constexpr int D = 2048, BATCH = 8, SEQ = 2048, MP = BATCH * SEQ;
constexpr int SB_ = 16, SN = 16, MS = SB_ * SN;
constexpr int R = MP + MS;
constexpr int PAST = 2048, NH = 16, DH = 64, AW = 1024, PW = 1024, FF = 8192;
constexpr int NKEY = PAST + SN;
constexpr int NMAIN = 8192;
constexpr int C_Q = 0, C_K = 1024, C_V = 2048, C_U = 3072, C_GA = 4096, C_GB = 6144;
constexpr float EPS = 1e-6f, LOG2E = 1.4426950408889634f, QSCALE = 0.125f * LOG2E;

constexpr size_t O_Y = 0;
constexpr size_t O_KP = (size_t)R * D;
constexpr size_t O_VP = O_KP + (size_t)MP * AW;
constexpr size_t O_LP = O_VP + (size_t)MP * AW;
constexpr size_t O_PP = O_LP + (size_t)MP * NH;
constexpr size_t O_KS = O_PP + (size_t)BATCH * 15 * PW;
constexpr size_t O_VS = O_KS + (size_t)MS * AW;
constexpr size_t O_LS = O_VS + (size_t)MS * AW;
constexpr size_t O_PS = O_LS + (size_t)MS * NH;
constexpr size_t O_END = O_PS + (size_t)SB_ * 15 * PW;

constexpr size_t MiB = 1u << 20;
constexpr size_t WS_WIN = 0, WS_WUP = 33 * MiB, WS_WPOOL = 37 * MiB, WS_WOUT = 38 * MiB, WS_WFF1 = 46 * MiB, WS_WFF2 = 78 * MiB;
constexpr size_t WS_H = 110 * MiB;
constexpr size_t WS_TM = 175 * MiB;
constexpr size_t WS_X = 240 * MiB;
constexpr size_t WS_Q = WS_X, WS_K = WS_Q + (size_t)R * AW * 2, WS_V = WS_K + (size_t)R * AW * 2, WS_U = WS_V + (size_t)R * AW * 2,
                 WS_PO = WS_U + (size_t)R * PW * 2, WS_SA = WS_PO + (size_t)R * PW * 2, WS_SB = WS_SA + (size_t)R * D * 2, WS_XEND = WS_SB + (size_t)R * D * 2;
constexpr size_t WS_Z = WS_X;
constexpr size_t WS_MO = WS_X;
constexpr size_t WS_FO = WS_H;
constexpr size_t WS_LOGF = 533 * MiB;
constexpr size_t WS_CP = 535 * MiB;
constexpr size_t WS_CS = 536 * MiB;
constexpr size_t WS_CTL = 540 * MiB;
constexpr size_t WS_SLAB = 541 * MiB;
constexpr size_t WS_END = 549 * MiB;
static_assert(WS_XEND <= WS_LOGF && WS_Z + (size_t)R * FF * 2 <= WS_LOGF, "ws map");

struct Params {
    const float *xp, *xs, *ck, *cv, *clf, *sp, *g_pre, *w_in, *b_f, *w_up, *w_pool, *pscale, *w_out, *g_post, *g_ffn_pre, *w_ff1, *w_ff2, *g_ffn_post;
    float* out; unsigned char* ws; int ph_lo, ph_hi;
};

__device__ __forceinline__ unsigned f2bf(float f) { unsigned u = __builtin_bit_cast(unsigned, f); return (u + 0x7fffu + ((u >> 16) & 1u)) >> 16; }
__device__ __forceinline__ unsigned pk2(float lo, float hi) { return f2bf(lo) | (f2bf(hi) << 16); }
__device__ __forceinline__ float bf2f(unsigned short b) { return __builtin_bit_cast(float, (unsigned)b << 16); }
__device__ __forceinline__ float bflo(unsigned w) { return __builtin_bit_cast(float, w << 16); }
__device__ __forceinline__ float bfhi(unsigned w) { return __builtin_bit_cast(float, w & 0xffff0000u); }
__device__ __forceinline__ float wave_sum(float v) {
#pragma unroll
    for (int o = 1; o < 64; o <<= 1) v += __shfl_xor(v, o);
    return v;
}
__device__ __forceinline__ int tid_opaque() { int t = threadIdx.x; asm volatile("" : "+v"(t)); return t; }
__device__ __forceinline__ float sigmoidf_(float x) { return __builtin_amdgcn_rcpf(1.0f + __builtin_amdgcn_exp2f(-LOG2E * x)); }
__device__ __forceinline__ const float* xrow(const Params& p, int row) { return row < MP ? p.xp + (size_t)row * D : p.xs + (size_t)(row - MP) * D; }

struct TrRegs { f32x4 v[8]; };
__device__ __forceinline__ void tr_load(TrRegs& t, const float* src, int ld, int col0, int k0, int nvalid, int lane) {
    const int n4 = (lane & 7) * 4;
#pragma unroll
    for (int i = 0; i < 8; ++i) { const int kk = 8 * i + (lane >> 3); t.v[i] = (n4 < nvalid) ? *(const f32x4*)(src + (size_t)(k0 + kk) * ld + col0 + n4) : (f32x4){0.f, 0.f, 0.f, 0.f}; }
}
__device__ __forceinline__ void tr_store(const TrRegs& t, bf16_t* dst, int pitch, int row0, int k0, int nvalid, float* scr, int lane) {
    const int n4 = (lane & 7) * 4;
#pragma unroll
    for (int i = 0; i < 8; ++i) { const int kk = 8 * i + (lane >> 3); float* q = scr + kk * 33 + n4; q[0] = t.v[i].x; q[1] = t.v[i].y; q[2] = t.v[i].z; q[3] = t.v[i].w; }
    __builtin_amdgcn_s_waitcnt(0xc07f); __builtin_amdgcn_wave_barrier();
    const int c = lane & 7;
#pragma unroll
    for (int j = 0; j < 4; ++j) { const int n = (lane >> 3) + 8 * j; const float* s = scr + (8 * c) * 33 + n;
        u32x4 o; o.x = pk2(s[0 * 33], s[1 * 33]); o.y = pk2(s[2 * 33], s[3 * 33]); o.z = pk2(s[4 * 33], s[5 * 33]); o.w = pk2(s[6 * 33], s[7 * 33]);
        if (n < nvalid) *(u32x4*)(dst + (size_t)(row0 + n) * pitch + k0 + 8 * c) = o; }
    __builtin_amdgcn_s_waitcnt(0xc07f); __builtin_amdgcn_wave_barrier();
}
struct TrItem { const float* src; bf16_t* dst; int ld, col0, k0, pitch, row0, nvalid; };
__device__ __forceinline__ TrItem tr_decode(const Params& p, int it) {
    bf16_t* Win = (bf16_t*)(p.ws + WS_WIN); bf16_t* Wup = (bf16_t*)(p.ws + WS_WUP); bf16_t* Wpool = (bf16_t*)(p.ws + WS_WPOOL);
    bf16_t* Wout = (bf16_t*)(p.ws + WS_WOUT); bf16_t* Wff1 = (bf16_t*)(p.ws + WS_WFF1); bf16_t* Wff2 = (bf16_t*)(p.ws + WS_WFF2);
    constexpr int NB_IN = 257;
    constexpr int I_IN = (D / 64) * NB_IN, I_UP = (AW / 64) * (D / 32), I_POOL = 4 * (256 / 64) * (512 / 32), I_OUT = (D / 64) * (D / 32), I_FF1 = (D / 64) * (FF / 32);
    int r = it;
    if (r < I_IN) { const int kb = r / NB_IN, nb = r % NB_IN, r0 = nb * 32;
        const int c0 = r0 < 3072 ? r0 : (r0 < NMAIN ? r0 + 16 : 3072 + (r0 - NMAIN));
        return TrItem{p.w_in, Win, 8208, c0, kb * 64, D, r0, r0 < NMAIN ? 32 : 16}; }
    r -= I_IN;
    if (r < I_UP) { const int nblk = D / 32; return TrItem{p.w_up, Wup, D, (r % nblk) * 32, (r / nblk) * 64, AW, (r % nblk) * 32, 32}; }
    r -= I_UP;
    if (r < I_POOL) { const int g = r / 64, q = r % 64, kb = q / 16, nb = q % 16; return TrItem{p.w_pool + (size_t)g * 256 * 512, Wpool, 512, nb * 32, kb * 64, 256, g * 512 + nb * 32, 32}; }
    r -= I_POOL;
    if (r < I_OUT) { const int nblk = D / 32; return TrItem{p.w_out, Wout, D, (r % nblk) * 32, (r / nblk) * 64, D, (r % nblk) * 32, 32}; }
    r -= I_OUT;
    if (r < I_FF1) { const int nblk = FF / 32; return TrItem{p.w_ff1, Wff1, FF, (r % nblk) * 32, (r / nblk) * 64, D, (r % nblk) * 32, 32}; }
    r -= I_FF1;
    { const int nblk = D / 32; return TrItem{p.w_ff2, Wff2, D, (r % nblk) * 32, (r / nblk) * 64, FF, (r % nblk) * 32, 32}; }
}
__device__ __forceinline__ void convert_weights(const Params& p, float* scr, int gw, int NGW, int lane) {
    constexpr int NITEMS = (D / 64) * 257 + (AW / 64) * (D / 32) + 4 * (256 / 64) * (512 / 32) + (D / 64) * (D / 32) + (D / 64) * (FF / 32) + (FF / 64) * (D / 32);
    if (gw >= NITEMS) return;
    TrItem cur = tr_decode(p, gw); TrRegs ra, rb;
    tr_load(ra, cur.src, cur.ld, cur.col0, cur.k0, cur.nvalid, lane);
    for (int it = gw; it < NITEMS; it += 2 * NGW) {
        const bool h1 = it + NGW < NITEMS; TrItem n1 = cur; if (h1) { n1 = tr_decode(p, it + NGW); tr_load(rb, n1.src, n1.ld, n1.col0, n1.k0, n1.nvalid, lane); }
        tr_store(ra, cur.dst, cur.pitch, cur.row0, cur.k0, cur.nvalid, scr, lane);
        const bool h2 = it + 2 * NGW < NITEMS; if (h2) { cur = tr_decode(p, it + 2 * NGW); tr_load(ra, cur.src, cur.ld, cur.col0, cur.k0, cur.nvalid, lane); }
        if (h1) tr_store(rb, n1.dst, n1.pitch, n1.row0, n1.k0, n1.nvalid, scr, lane);
    }
}

__device__ __forceinline__ void rms_row_to_bf16(const float* xr_, const float* g, bf16_t* orow, int lane) {
    const f32x4* xr = (const f32x4*)xr_ + lane; const f32x4* gr = (const f32x4*)g + lane;
    f32x4 v[8]; float s = 0.f;
#pragma unroll
    for (int j = 0; j < 8; ++j) { v[j] = xr[64 * j]; s += (v[j].x * v[j].x + v[j].y * v[j].y) + (v[j].z * v[j].z + v[j].w * v[j].w); }
    const float rstd = rsqrtf(wave_sum(s) * (1.f / D) + EPS);
    u32x2* o8 = (u32x2*)orow + lane;
#pragma unroll
    for (int j = 0; j < 8; ++j) { const f32x4 gg = gr[64 * j]; u32x2 w; w.x = pk2(v[j].x * rstd * gg.x, v[j].y * rstd * gg.y); w.y = pk2(v[j].z * rstd * gg.z, v[j].w * rstd * gg.w); o8[64 * j] = w; }
}
template <int WM, int WN, int TM, int TN, class Epi>
__device__ __forceinline__ void sgemm_tile(unsigned char* smem, const bf16_t* __restrict__ A, int lda, const bf16_t* __restrict__ Bt, int ldb, int K, int row0, int col0, const Epi& E) {
    static_assert(WM * WN == 8, "8 waves");
    constexpr int BM = WM * TM * 16, BN = WN * TN * 16, CA = BM * 8, CB = BN * 8, NA = (CA + 511) / 512, NB = (CB + 511) / 512;
    const int tid = threadIdx.x, lane = tid & 63, wid = tid >> 6, wr = wid / WN, wc = wid % WN, fr = lane & 15, fq = lane >> 4;
    unsigned char* sA = smem; unsigned char* sB = smem + BM * 128;
    f32x4 acc[TM][TN];
#pragma unroll
    for (int m = 0; m < TM; ++m)
#pragma unroll
        for (int n = 0; n < TN; ++n) acc[m][n] = (f32x4){0.f, 0.f, 0.f, 0.f};
    u32x4 ra[NA], rb[NB];
    const int nk = K / 64;
#define SG_GLOAD(kt) do { \
    _Pragma("unroll") for (int i = 0; i < NA; ++i) { const int c = tid + i * 512; if (c < CA) ra[i] = *(const u32x4*)(A + (size_t)(row0 + (c >> 3)) * lda + (kt) * 64 + (c & 7) * 8); } \
    _Pragma("unroll") for (int i = 0; i < NB; ++i) { const int c = tid + i * 512; if (c < CB) rb[i] = *(const u32x4*)(Bt + (size_t)(col0 + (c >> 3)) * ldb + (kt) * 64 + (c & 7) * 8); } } while (0)
    SG_GLOAD(0);
    for (int kt = 0; kt < nk; ++kt) {
        __syncthreads();
#pragma unroll
        for (int i = 0; i < NA; ++i) { const int c = tid + i * 512; if (c < CA) { const int r = c >> 3, ch = c & 7; *(u32x4*)(sA + r * 128 + ((ch ^ (r & 7)) << 4)) = ra[i]; } }
#pragma unroll
        for (int i = 0; i < NB; ++i) { const int c = tid + i * 512; if (c < CB) { const int r = c >> 3, ch = c & 7; *(u32x4*)(sB + r * 128 + ((ch ^ (r & 7)) << 4)) = rb[i]; } }
        __syncthreads();
        if (kt + 1 < nk) SG_GLOAD(kt + 1);
#pragma unroll
        for (int kk = 0; kk < 2; ++kk) {
            bf16x8 af[TM], bfr[TN];
#pragma unroll
            for (int m = 0; m < TM; ++m) { const int r = (wr * TM + m) * 16 + fr, ch = kk * 4 + fq; af[m] = *(const bf16x8*)(sA + r * 128 + ((ch ^ (r & 7)) << 4)); }
#pragma unroll
            for (int n = 0; n < TN; ++n) { const int r = (wc * TN + n) * 16 + fr, ch = kk * 4 + fq; bfr[n] = *(const bf16x8*)(sB + r * 128 + ((ch ^ (r & 7)) << 4)); }
#pragma unroll
            for (int m = 0; m < TM; ++m)
#pragma unroll
                for (int n = 0; n < TN; ++n) acc[m][n] = __builtin_amdgcn_mfma_f32_16x16x32_bf16(bfr[n], af[m], acc[m][n], 0, 0, 0);
        }
    }
#undef SG_GLOAD
#pragma unroll
    for (int m = 0; m < TM; ++m)
#pragma unroll
        for (int n = 0; n < TN; ++n) E(row0 + (wr * TM + m) * 16 + fr, col0 + (wc * TN + n) * 16 + 4 * fq, acc[m][n]);
}

__device__ __forceinline__ void st_bf16x4(bf16_t* p, f32x4 v) { u32x2 w; w.x = pk2(v.x, v.y); w.y = pk2(v.z, v.w); *(u32x2*)p = w; }
__device__ __forceinline__ void st_bf16x8(bf16_t* p, f32x4 a, f32x4 b) { u32x4 w; w.x = pk2(a.x, a.y); w.y = pk2(a.z, a.w); w.z = pk2(b.x, b.y); w.w = pk2(b.z, b.w); *(u32x4*)p = w; }
__device__ __forceinline__ void ld_bf16x8(const bf16_t* p, f32x4& a, f32x4& b) { const u32x4 w = *(const u32x4*)p; a = (f32x4){bflo(w.x), bfhi(w.x), bflo(w.y), bfhi(w.y)}; b = (f32x4){bflo(w.z), bfhi(w.z), bflo(w.w), bfhi(w.w)}; }
__device__ __forceinline__ f32x4 sig4(f32x4 v) { return (f32x4){sigmoidf_(v.x), sigmoidf_(v.y), sigmoidf_(v.z), sigmoidf_(v.w)}; }
__device__ __forceinline__ f32x4 ld_bf16x4(const bf16_t* p) { const u32x2 w = *(const u32x2*)p; return (f32x4){bflo(w.x), bfhi(w.x), bflo(w.y), bfhi(w.y)}; }

struct EpiIn {
    bf16_t *Q, *Kb, *Vb, *U, *SA, *SB; float* out; const float* pscale;
    __device__ __forceinline__ void operator()(int row, int col, f32x4 v) const {
        if (col < C_K) { st_bf16x4(Q + (size_t)row * AW + col, v * QSCALE); }
        else if (col < C_U) {
            const bool isk = col < C_V; const int c = col - (isk ? C_K : C_V);
            st_bf16x4((isk ? Kb : Vb) + (size_t)row * AW + c, v);
            float* o = row < MP ? out + (isk ? O_KP : O_VP) + (size_t)row * AW + c : out + (isk ? O_KS : O_VS) + (size_t)(row - MP) * AW + c;
            *(f32x4*)o = v;
        } else if (col < C_GA) {
            const int c = col - C_U; st_bf16x4(U + (size_t)row * PW + c, v);
            if (row < MP) { const int b = row / SEQ, t = row % SEQ; if (t >= SEQ - 15) *(f32x4*)(out + O_PP + ((size_t)b * 15 + (t - (SEQ - 15))) * PW + c) = v; }
            else { const int rs = row - MP, b = rs / SN, i = rs % SN; if (i >= 1) *(f32x4*)(out + O_PS + ((size_t)b * 15 + (i - 1)) * PW + c) = v; }
        } else if (col < C_GB) { const int c = col - C_GA; f32x4 s = {sigmoidf_(v.x), sigmoidf_(v.y), sigmoidf_(v.z), sigmoidf_(v.w)}; st_bf16x4(SA + (size_t)row * D + c, s); }
        else { const int c = col - C_GB; const f32x4 ps = *(const f32x4*)(pscale + c); f32x4 s = {sigmoidf_(v.x) * ps.x, sigmoidf_(v.y) * ps.y, sigmoidf_(v.z) * ps.z, sigmoidf_(v.w) * ps.w}; st_bf16x4(SB + (size_t)row * D + c, s); }
    }
    __device__ __forceinline__ void op8(int row, int col, f32x4 a, f32x4 b) const {
        if (col < C_K) { st_bf16x8(Q + (size_t)row * AW + col, a * QSCALE, b * QSCALE); }
        else if (col < C_U) { const bool isk = col < C_V; const int c = col - (isk ? C_K : C_V);
            st_bf16x8((isk ? Kb : Vb) + (size_t)row * AW + c, a, b);
            float* o = out + (isk ? O_KP : O_VP) + (size_t)row * AW + c; *(f32x4*)o = a; *(f32x4*)(o + 4) = b;
        } else if (col < C_GA) { const int c = col - C_U; st_bf16x8(U + (size_t)row * PW + c, a, b);
            const int bb = row / SEQ, t = row % SEQ; if (t >= SEQ - 15) { float* o = out + O_PP + ((size_t)bb * 15 + (t - (SEQ - 15))) * PW + c; *(f32x4*)o = a; *(f32x4*)(o + 4) = b; }
        } else if (col < C_GB) { st_bf16x8(SA + (size_t)row * D + (col - C_GA), sig4(a), sig4(b)); }
        else { const int c = col - C_GB; const f32x4 p0 = *(const f32x4*)(pscale + c), p1 = *(const f32x4*)(pscale + c + 4); st_bf16x8(SB + (size_t)row * D + c, sig4(a) * p0, sig4(b) * p1); }
    }
};
struct EpiLogf {
    float* LOGF; float* out; const float* b_f;
    __device__ __forceinline__ void operator()(int row, int col, f32x4 v) const {
        const f32x4 b = *(const f32x4*)(b_f + col); f32x4 r;
#pragma unroll
        for (int e = 0; e < 4; ++e) { const float z = v[e] + b[e]; r[e] = fminf(z, 0.f) - log1pf(__expf(-fabsf(z))); }
        *(f32x4*)(LOGF + (size_t)row * NH + col) = r;
        float* o = row < MP ? out + O_LP + (size_t)row * NH + col : out + O_LS + (size_t)(row - MP) * NH + col;
        *(f32x4*)o = r;
    }
};
__device__ __forceinline__ float wave_incl_scan(float v, int lane) {
#pragma unroll
    for (int o = 1; o < 64; o <<= 1) { const float t = __shfl_up(v, o); if (lane >= o) v += t; }
    return v;
}
__device__ __forceinline__ void pool_chunk(const Params& p, int row, int ch) {
    const bf16_t* U = (const bf16_t*)(p.ws + WS_U); bf16_t* PO = (bf16_t*)(p.ws + WS_PO);
    const int c0 = ch * 8, g = c0 >> 8, w = 2 << g;
    float s[8]; float cur[8];
#pragma unroll
    for (int e = 0; e < 8; ++e) s[e] = 0.f;
    float cnt;
    if (row < MP) { const int t = row % SEQ; const int n = (t + 1 < w) ? t + 1 : w; cnt = (float)n;
        for (int j = 0; j < n; ++j) { const u32x4 v = *(const u32x4*)(U + (size_t)(row - j) * PW + c0);
            const float f[8] = {bflo(v.x), bfhi(v.x), bflo(v.y), bfhi(v.y), bflo(v.z), bfhi(v.z), bflo(v.w), bfhi(v.w)};
#pragma unroll
            for (int e = 0; e < 8; ++e) { s[e] += f[e]; if (j == 0) cur[e] = f[e]; } }
    } else { const int rs = row - MP, b = rs / SN, i = rs % SN; cnt = (float)w;
        for (int j = 0; j < w; ++j) { const int e_ = 15 + i - j;
            float f[8];
            if (e_ >= 15) { const u32x4 v = *(const u32x4*)(U + (size_t)(MP + b * SN + (e_ - 15)) * PW + c0);
                f[0] = bflo(v.x); f[1] = bfhi(v.x); f[2] = bflo(v.y); f[3] = bfhi(v.y); f[4] = bflo(v.z); f[5] = bfhi(v.z); f[6] = bflo(v.w); f[7] = bfhi(v.w); }
            else { const f32x4 a = *(const f32x4*)(p.sp + ((size_t)b * 15 + e_) * PW + c0), c = *(const f32x4*)(p.sp + ((size_t)b * 15 + e_) * PW + c0 + 4);
                f[0] = a.x; f[1] = a.y; f[2] = a.z; f[3] = a.w; f[4] = c.x; f[5] = c.y; f[6] = c.z; f[7] = c.w; }
#pragma unroll
            for (int e = 0; e < 8; ++e) { s[e] += f[e]; if (j == 0) cur[e] = f[e]; } }
    }
    u32x4 o; o.x = pk2(s[0] / cnt - cur[0], s[1] / cnt - cur[1]); o.y = pk2(s[2] / cnt - cur[2], s[3] / cnt - cur[3]); o.z = pk2(s[4] / cnt - cur[4], s[5] / cnt - cur[5]); o.w = pk2(s[6] / cnt - cur[6], s[7] / cnt - cur[7]);
    *(u32x4*)(PO + (size_t)row * PW + c0) = o;
}
struct EpiPool { const bf16_t* SB; bf16_t* T;
    __device__ __forceinline__ void operator()(int row, int col, f32x4 v) const { const f32x4 s = ld_bf16x4(SB + (size_t)row * D + col); st_bf16x4(T + (size_t)row * D + col, v * s); }
    __device__ __forceinline__ void op8(int row, int col, f32x4 a, f32x4 b) const { f32x4 s0, s1; ld_bf16x8(SB + (size_t)row * D + col, s0, s1); st_bf16x8(T + (size_t)row * D + col, a * s0, b * s1); } };
struct EpiUp { const bf16_t* SA; bf16_t* T;
    __device__ __forceinline__ void operator()(int row, int col, f32x4 v) const { const f32x4 s = ld_bf16x4(SA + (size_t)row * D + col), t = ld_bf16x4(T + (size_t)row * D + col); st_bf16x4(T + (size_t)row * D + col, v * s + t); }
    __device__ __forceinline__ void op8(int row, int col, f32x4 a, f32x4 b) const { f32x4 s0, s1, t0, t1; ld_bf16x8(SA + (size_t)row * D + col, s0, s1); ld_bf16x8(T + (size_t)row * D + col, t0, t1); st_bf16x8(T + (size_t)row * D + col, a * s0 + t0, b * s1 + t1); } };
struct EpiF32 { float* C; int ldc;
    __device__ __forceinline__ void operator()(int row, int col, f32x4 v) const { *(f32x4*)(C + (size_t)row * ldc + col) = v; } };
struct EpiRelu2 { bf16_t* Z;
    __device__ __forceinline__ void operator()(int row, int col, f32x4 v) const { f32x4 r;
#pragma unroll
        for (int e = 0; e < 4; ++e) { const float a = fmaxf(v[e], 0.f); r[e] = a * a; }
        st_bf16x4(Z + (size_t)row * FF + col, r); }
    __device__ __forceinline__ void op8(int row, int col, f32x4 a, f32x4 b) const { const f32x4 z = {0.f, 0.f, 0.f, 0.f}; a = __builtin_elementwise_max(a, z); b = __builtin_elementwise_max(b, z); st_bf16x8(Z + (size_t)row * FF + col, a * a, b * b); } };

namespace pg8 {
#define PG8_LAS __attribute__((address_space(3)))


constexpr int BM = 256, BK = 64, HALF = 128, HTB = HALF * BK * 2  , STAGE_BYTES = 8 * HTB, NXCD = 8, WGM = 8;

__host__ __device__ __forceinline__ int lds_byte(int r, int c) { const int st = (r >> 4) * 2 + (c >> 5), rr = r & 15, cc = c & 31, ob = rr * 64 + cc * 2; return st * 1024 + (ob ^ (((ob >> 9) & 1) << 5)); }
__host__ __device__ __forceinline__ void stage_rc(int b, int& R, int& C) { const int st = b / 1024, sb = b % 1024, swz = sb ^ (((sb >> 9) & 1) << 5); R = (st >> 1) * 16 + swz / 64; C = (st & 1) * 32 + (swz % 64) / 2; }
__host__ __device__ __forceinline__ int perm32(int rho) { const int n = rho >> 4, i = rho & 15; return 8 * (i >> 2) + 4 * n + (i & 3); }

struct Unit { int pm, pn; };
struct Gemm { const bf16_t* A; const bf16_t* Bt; int M, N, K, lda, agrp; };

struct StaticOrder {
    int nM, nN, nwg, G, c;
    __host__ __device__ void init(int M, int N, int G_, int c_) { nM = M / BM; nN = N / BM; nwg = nM * nN; G = G_; c = c_; }
    __host__ __device__ bool next(int i, Unit& u) const {
        const long L = (long)i * G + c; if (L >= nwg) return false;
        int wgid = (int)L; { const int q = nwg / NXCD, r = nwg % NXCD, xcd = wgid % NXCD, off = wgid / NXCD; wgid = (xcd < r ? xcd * (q + 1) : r * (q + 1) + (xcd - r) * q) + off; }
        const int nig = WGM * nN, gid = wgid / nig, fm = gid * WGM, gsz = (nM - fm) < WGM ? (nM - fm) : WGM;
        u.pm = fm + ((wgid % nig) % gsz); u.pn = (wgid % nig) / gsz; return true;
    }
    __device__ __forceinline__ void a_ready(const Unit&) const {}
    __device__ __forceinline__ void done(const Unit&) const {}
};

template <class Epi, class Sched, bool ALIGN_EPI = false, bool SP2 = false>
__device__ __forceinline__ void gemm_phase(PG8_LAS unsigned char* lds, const Gemm g, const Sched& S, const Epi& E) {
    const int tid = tid_opaque(), wid = __builtin_amdgcn_readfirstlane(tid >> 6), lane = tid & 63, wr = wid >> 2, wc = wid & 3, fr = lane & 15, fq = lane >> 4;
    const int K = g.K, nt = K / BK;
    unsigned voffA[2], voffB[2];
#pragma unroll
    for (int i = 0; i < 2; ++i) { int R, C; stage_rc(tid * 16 + i * 8192, R, C); const int Rb = Epi::PERM ? ((R & ~31) + perm32(R & 31)) : R;
        voffA[i] = (unsigned)(R * g.lda + C) * 2u; voffB[i] = (unsigned)(Rb * K + C) * 2u; }
    const size_t kstep = (size_t)(BK * 2);
    const size_t hstepA = (size_t)HALF * g.lda * 2, hstepB = (size_t)HALF * K * 2;
    const size_t tstepA = 2 * hstepA, tstepB = 2 * hstepB;
    const unsigned ldsw = (unsigned)wid * 1024u;
    const int aoff = lds_byte(wr * 64 + fr, fq * 8), boff = lds_byte(wc * 32 + fr, fq * 8);
#define PG8_SA(b, h) (((b) * 2 + (h)) * HTB)
#define PG8_SB(b, h) ((4 + (b) * 2 + (h)) * HTB)
#define PG8_STAGE(bufoff, gbase, voff) do { _Pragma("unroll") for (int _i = 0; _i < 2; ++_i) \
        __builtin_amdgcn_global_load_lds((const unsigned*)((const char*)(gbase) + (voff)[_i]), (PG8_LAS unsigned*)(lds + (bufoff) + ldsw + _i * 8192), 16, 0, 0); } while (0)
#define PG8_LDA(dst, b, h) do { _Pragma("unroll") for (int m = 0; m < 4; ++m) _Pragma("unroll") for (int k = 0; k < 2; ++k) dst[m][k] = *(const PG8_LAS bf16x8*)(lds + PG8_SA(b, h) + aoff + m * 2048 + k * 1024); } while (0)
#define PG8_LDB(dst, b, h) do { _Pragma("unroll") for (int n = 0; n < 2; ++n) _Pragma("unroll") for (int k = 0; k < 2; ++k) dst[n][k] = *(const PG8_LAS bf16x8*)(lds + PG8_SB(b, h) + boff + n * 2048 + k * 1024); } while (0)
#define PG8_MMA(ai, bj, At, Bt) do { __builtin_amdgcn_s_setprio(1); _Pragma("unroll") for (int m = 0; m < 4; ++m) _Pragma("unroll") for (int n = 0; n < 2; ++n) _Pragma("unroll") for (int k = 0; k < 2; ++k) \
        acc[ai][bj][m][n] = __builtin_amdgcn_mfma_f32_16x16x32_bf16(Bt[n][k], At[m][k], acc[ai][bj][m][n], 0, 0, 0); __builtin_amdgcn_s_setprio(0); } while (0)
#define PG8_WAIT_V(n) asm volatile("s_waitcnt vmcnt(" #n ")" ::: "memory")
#define PG8_WAIT_L(n) asm volatile("s_waitcnt lgkmcnt(" #n ")" ::: "memory")
#define PG8_BAR __builtin_amdgcn_s_barrier()
#define PG8_SCHED __builtin_amdgcn_sched_barrier(0)
    Unit cur, nxt; int ui = 0;
    if (!S.next(0, cur)) return;
    f32x4 acc[2][2][4][2];
#pragma unroll
    for (int a = 0; a < 2; ++a)
#pragma unroll
        for (int b = 0; b < 2; ++b)
#pragma unroll
            for (int m = 0; m < 4; ++m)
#pragma unroll
                for (int n = 0; n < 2; ++n) acc[a][b][m][n] = (f32x4){0.f, 0.f, 0.f, 0.f};
    bf16x8 At[4][2], B0[2][2], B1[2][2];
    const char* cA = (const char*)g.A + (size_t)cur.pm * tstepA + (size_t)((cur.pn >> 1) * g.agrp) * 2; const char* cB = (const char*)g.Bt + (size_t)cur.pn * tstepB;
    S.a_ready(cur);
    if constexpr (SP2) {
        PG8_STAGE(PG8_SB(0, 0), cB, voffB); PG8_STAGE(PG8_SB(0, 1), cB + hstepB, voffB); PG8_STAGE(PG8_SA(0, 0), cA, voffA); PG8_STAGE(PG8_SA(0, 1), cA + hstepA, voffA);
        if (wr == 1) PG8_BAR;
        PG8_WAIT_V(2); PG8_BAR;
        PG8_STAGE(PG8_SB(1, 0), cB + kstep, voffB); PG8_STAGE(PG8_SA(1, 0), cA + kstep, voffA); PG8_STAGE(PG8_SB(1, 1), cB + hstepB + kstep, voffB);
        PG8_WAIT_V(6); PG8_BAR;
    } else {
        PG8_STAGE(PG8_SB(0, 0), cB, voffB); PG8_STAGE(PG8_SA(0, 0), cA, voffA); PG8_STAGE(PG8_SB(0, 1), cB + hstepB, voffB); PG8_STAGE(PG8_SA(0, 1), cA + hstepA, voffA);
        if (wr == 1) PG8_BAR;
        PG8_WAIT_V(4); PG8_BAR;
        PG8_STAGE(PG8_SB(1, 0), cB + kstep, voffB); PG8_STAGE(PG8_SA(1, 0), cA + kstep, voffA); PG8_STAGE(PG8_SB(1, 1), cB + hstepB + kstep, voffB);
        PG8_WAIT_V(6); PG8_BAR;
    }
    for (;;) {
        const bool has_next = S.next(ui + 1, nxt);
        const char* nA = has_next ? (const char*)g.A + (size_t)nxt.pm * tstepA + (size_t)((nxt.pn >> 1) * g.agrp) * 2 : cA; const char* nB = has_next ? (const char*)g.Bt + (size_t)nxt.pn * tstepB : cB;
        for (int t = 0; t < nt; t += 2) {
            const bool last = (t == nt - 2);
            const char* a1 = cA + (size_t)(t + 1) * kstep;
            const char* a2 = last ? nA : cA + (size_t)(t + 2) * kstep; const char* b2 = last ? nB : cB + (size_t)(t + 2) * kstep;
            const char* a3 = a2 + kstep; const char* b3 = b2 + kstep;
            if (last && has_next) S.a_ready(nxt);
            if constexpr (SP2) {
            PG8_LDB(B0, 0, 0); PG8_LDB(B1, 0, 1); PG8_SCHED; PG8_LDA(At, 0, 0); PG8_STAGE(PG8_SA(1, 1), a1 + hstepA, voffA);
            PG8_WAIT_V(8); PG8_WAIT_L(0); PG8_BAR; PG8_MMA(0, 0, At, B0); PG8_MMA(0, 1, At, B1); PG8_BAR; PG8_SCHED;
            PG8_LDA(At, 0, 1); PG8_STAGE(PG8_SB(0, 0), b2, voffB); PG8_STAGE(PG8_SB(0, 1), b2 + hstepB, voffB); PG8_STAGE(PG8_SA(0, 0), a2, voffA);
            PG8_WAIT_V(8); PG8_WAIT_L(0); PG8_BAR; PG8_MMA(1, 0, At, B0); PG8_MMA(1, 1, At, B1); PG8_BAR; PG8_SCHED;
            PG8_LDB(B0, 1, 0); PG8_LDB(B1, 1, 1); PG8_SCHED; PG8_LDA(At, 1, 0); PG8_STAGE(PG8_SA(0, 1), a2 + hstepA, voffA);
            PG8_WAIT_V(8); PG8_WAIT_L(0); PG8_BAR; PG8_MMA(0, 0, At, B0); PG8_MMA(0, 1, At, B1); PG8_BAR; PG8_SCHED;
            PG8_LDA(At, 1, 1); PG8_STAGE(PG8_SB(1, 0), b3, voffB); PG8_STAGE(PG8_SB(1, 1), b3 + hstepB, voffB); PG8_STAGE(PG8_SA(1, 0), a3, voffA);
            PG8_WAIT_V(8); PG8_WAIT_L(0); PG8_BAR; PG8_MMA(1, 0, At, B0); PG8_MMA(1, 1, At, B1); PG8_BAR; PG8_SCHED;
            } else {
            PG8_LDB(B0, 0, 0); PG8_SCHED; PG8_LDA(At, 0, 0); PG8_STAGE(PG8_SA(1, 1), a1 + hstepA, voffA);
            PG8_WAIT_L(8); PG8_BAR; PG8_WAIT_L(0); PG8_MMA(0, 0, At, B0); PG8_BAR; PG8_SCHED;
            PG8_LDB(B1, 0, 1); PG8_STAGE(PG8_SB(0, 0), b2, voffB);
            PG8_BAR; PG8_WAIT_L(0); PG8_MMA(0, 1, At, B1); PG8_BAR;
            PG8_LDA(At, 0, 1); PG8_STAGE(PG8_SA(0, 0), a2, voffA);
            PG8_BAR; PG8_WAIT_L(0); PG8_MMA(1, 0, At, B0); PG8_BAR; PG8_SCHED;
            PG8_STAGE(PG8_SB(0, 1), b2 + hstepB, voffB);
            PG8_WAIT_V(6); PG8_BAR; PG8_MMA(1, 1, At, B1); PG8_BAR;
            PG8_LDB(B0, 1, 0); PG8_SCHED; PG8_LDA(At, 1, 0); PG8_STAGE(PG8_SA(0, 1), a2 + hstepA, voffA);
            PG8_WAIT_L(8); PG8_BAR; PG8_WAIT_L(0); PG8_MMA(0, 0, At, B0); PG8_BAR; PG8_SCHED;
            PG8_LDB(B1, 1, 1); PG8_STAGE(PG8_SB(1, 0), b3, voffB);
            PG8_BAR; PG8_WAIT_L(0); PG8_MMA(0, 1, At, B1); PG8_BAR;
            PG8_LDA(At, 1, 1); PG8_STAGE(PG8_SA(1, 0), a3, voffA);
            PG8_BAR; PG8_WAIT_L(0); PG8_MMA(1, 0, At, B0); PG8_BAR; PG8_SCHED;
            PG8_STAGE(PG8_SB(1, 1), b3 + hstepB, voffB);
            PG8_WAIT_V(6); PG8_BAR; PG8_MMA(1, 1, At, B1); PG8_BAR;
            }
        }
        if constexpr (ALIGN_EPI) { if (wr == 0) PG8_BAR; }
        if constexpr (!Epi::AFTER_DRAIN) { E(acc, cur, wr, wc, fr, fq); S.done(cur); }
        if (!has_next) break;
#pragma unroll
        for (int a = 0; a < 2; ++a)
#pragma unroll
            for (int b = 0; b < 2; ++b)
#pragma unroll
                for (int m = 0; m < 4; ++m)
#pragma unroll
                    for (int n = 0; n < 2; ++n) acc[a][b][m][n] = (f32x4){0.f, 0.f, 0.f, 0.f};
        cur = nxt; cA = nA; cB = nB; ++ui;
        if constexpr (ALIGN_EPI) { if (wr == 1) PG8_BAR; }
    }
    PG8_WAIT_V(0);
    if constexpr (!ALIGN_EPI) { if (wr == 0) PG8_BAR; }
    PG8_BAR;
    if constexpr (Epi::AFTER_DRAIN) { E.fused(acc, cur, wr, wc, fr, fq, lds, wid, lane); S.done(cur); }
#undef PG8_SA
#undef PG8_SB
#undef PG8_STAGE
#undef PG8_LDA
#undef PG8_LDB
#undef PG8_MMA
#undef PG8_WAIT_V
#undef PG8_WAIT_L
#undef PG8_BAR
#undef PG8_SCHED
}
}

#include <hip/hip_bf16.h>
#include <cmath>
namespace attn_body {
using bf16=__hip_bfloat16;
using bf16x8=__attribute__((ext_vector_type(8)))short;
using s16x4=__attribute__((ext_vector_type(4)))short;
using f32x16=__attribute__((ext_vector_type(16)))float;
using u32x4=__attribute__((ext_vector_type(4)))unsigned;
constexpr int BATCH=8,NHEAD=16,SEQ=2048,D=64,DM=NHEAD*D;
constexpr int NW=8,QBLK=32,QB=QBLK*NW,KVBLK=64,NQB=SEQ/QB;
constexpr int ATTN_PITCH=DM, ATTN_UNIT_ROWS=QB;
__device__ __forceinline__ int crow(int r,int hi){return (r&3)+8*(r>>2)+4*hi;}
#define SBAR() __builtin_amdgcn_sched_barrier(0)
__device__ __forceinline__ void cmask(f32x16&p0,f32x16&p1,int jb,int qrel,int hi){
  const float NEG=-INFINITY; int kb=64*jb+4*hi;
  #pragma unroll
  for(int r=0;r<16;++r){int kv=kb+(r&3)+8*(r>>2); if(kv>qrel)p0[r]=NEG; if(kv+32>qrel)p1[r]=NEG;}
}

constexpr int NSLOT=3, SLOTB=8192;
constexpr int LDS_K=0, LDS_V=NSLOT*SLOTB, LDS_WS=2*NSLOT*SLOTB, LDS_OST=LDS_WS+NW*64*4, LDS_BYTES=LDS_OST+NW*4096;
constexpr float C2=0.125f*1.4426950408889634f;
__device__ __forceinline__ void glds16(const void*gsrc,unsigned lds_dst){unsigned keep;
  asm volatile("s_mov_b32 %0, m0\n\ts_mov_b32 m0, %2\n\ts_nop 0\n\tglobal_load_lds_dwordx4 %1, off\n\ts_mov_b32 m0, %0":"=&s"(keep):"v"(gsrc),"s"(lds_dst):"memory");}
__device__ __forceinline__ float max3f(float a,float b,float c){float r;asm("v_max3_f32 %0, %1, %2, %3":"=v"(r):"v"(a),"v"(b),"v"(c));return r;}
__device__ __forceinline__ float max2f(float a,float b){float r;asm("v_max_f32_e32 %0, %1, %2":"=v"(r):"v"(a),"v"(b));return r;}
__device__ __forceinline__ float fadd_s(float a,float b){float r;asm("v_add_f32_e32 %0, %1, %2":"=v"(r):"v"(a),"v"(b));return r;}
__device__ __forceinline__ float fsub_s(float a,float b){float r;asm("v_sub_f32_e32 %0, %1, %2":"=v"(r):"v"(a),"v"(b));return r;}
typedef float f32x2_t __attribute__((ext_vector_type(2))); typedef __bf16 bf16x2_t __attribute__((ext_vector_type(2)));
__device__ __forceinline__ unsigned cvtpk_s(float lo,float hi){f32x2_t v={lo,hi};bf16x2_t b=__builtin_convertvector(v,bf16x2_t);return __builtin_bit_cast(unsigned,b);}
#define WAIT_BAR(N) asm volatile("s_waitcnt vmcnt(" #N ") lgkmcnt(0)\n\ts_barrier":::"memory")

__device__ __forceinline__ void qkt(f32x16&p0,f32x16&p1,const char*Kslot,const bf16x8*qr,int r32,int hi){
  const char*kb=Kslot+hi*1024+r32*16;
  #pragma unroll
  for(int d0=0;d0<4;++d0){
    const bf16x8 b0=*reinterpret_cast<const bf16x8*>(kb+d0*2048);
    const bf16x8 b1=*reinterpret_cast<const bf16x8*>(kb+d0*2048+512);
    if(d0==0){p0=__builtin_amdgcn_mfma_f32_32x32x16_bf16(b0,qr[0],p0,0,0,0);p1=__builtin_amdgcn_mfma_f32_32x32x16_bf16(b1,qr[0],p1,0,0,0);}
    else{p0=__builtin_amdgcn_mfma_f32_32x32x16_bf16(b0,qr[d0],p0,0,0,0);p1=__builtin_amdgcn_mfma_f32_32x32x16_bf16(b1,qr[d0],p1,0,0,0);}}
}
typedef __attribute__((address_space(3))) const char* lds_cptr;
typedef short v4i16_t __attribute__((ext_vector_type(4)));
__device__ __forceinline__ void kload8(bf16x8*kf,lds_cptr kp){
  kf[0]=*(const __attribute__((address_space(3))) bf16x8*)(kp);      kf[1]=*(const __attribute__((address_space(3))) bf16x8*)(kp+512);
  kf[2]=*(const __attribute__((address_space(3))) bf16x8*)(kp+2048); kf[3]=*(const __attribute__((address_space(3))) bf16x8*)(kp+2560);
  kf[4]=*(const __attribute__((address_space(3))) bf16x8*)(kp+4096); kf[5]=*(const __attribute__((address_space(3))) bf16x8*)(kp+4608);
  kf[6]=*(const __attribute__((address_space(3))) bf16x8*)(kp+6144); kf[7]=*(const __attribute__((address_space(3))) bf16x8*)(kp+6656);
}
__device__ __forceinline__ void kload2(bf16x8*kf,lds_cptr kp,int j){ kf[2*j]=*(const __attribute__((address_space(3))) bf16x8*)(kp+j*2048); kf[2*j+1]=*(const __attribute__((address_space(3))) bf16x8*)(kp+j*2048+512); }
__device__ __forceinline__ s16x4 vtr(lds_cptr p){ return __builtin_bit_cast(s16x4,__builtin_amdgcn_ds_read_tr16_b64_v4i16((__attribute__((address_space(3))) v4i16_t*)p)); }
__device__ __forceinline__ float rowmax(const f32x16&p0,const f32x16&p1){
  float a=max3f(p0[0],p0[1],p1[0]),b=max3f(p0[2],p0[3],p1[1]);a=max3f(a,p1[2],p1[3]);
  #pragma unroll
  for(int r=4;r<16;r+=4){a=max3f(a,p0[r],p0[r+1]);b=max3f(b,p0[r+2],p0[r+3]);a=max3f(a,p1[r],p1[r+1]);b=max3f(b,p1[r+2],p1[r+3]);}
  const float m=max2f(a,b);
  auto rr=__builtin_amdgcn_permlane32_swap(__float_as_uint(m),__float_as_uint(m),false,false);
  return max2f(__uint_as_float(rr[0]),__uint_as_float(rr[1]));
}
__device__ __forceinline__ void pv(f32x16*o,int vb,bf16x8 pa0,bf16x8 pa1,bf16x8 pa2,bf16x8 pa3){
  #pragma unroll
  for(int d0=0;d0<2;++d0){s16x4 lo[4],hi[4];
    #pragma unroll
    for(int ks=0;ks<4;++ks){
      asm volatile("ds_read_b64_tr_b16 %0,%1 offset:%c2":"=&v"(lo[ks]):"v"(vb),"i"(d0*4096+ks*1024):"memory");
      asm volatile("ds_read_b64_tr_b16 %0,%1 offset:%c2":"=&v"(hi[ks]):"v"(vb),"i"(d0*4096+ks*1024+512):"memory");}
    asm volatile("s_waitcnt lgkmcnt(0)":::"memory");SBAR();
    #define PK(k) (bf16x8){lo[k][0],lo[k][1],lo[k][2],lo[k][3],hi[k][0],hi[k][1],hi[k][2],hi[k][3]}
    o[d0]=__builtin_amdgcn_mfma_f32_32x32x16_bf16(pa0,PK(0),o[d0],0,0,0);
    o[d0]=__builtin_amdgcn_mfma_f32_32x32x16_bf16(pa1,PK(1),o[d0],0,0,0);
    o[d0]=__builtin_amdgcn_mfma_f32_32x32x16_bf16(pa2,PK(2),o[d0],0,0,0);
    o[d0]=__builtin_amdgcn_mfma_f32_32x32x16_bf16(pa3,PK(3),o[d0],0,0,0);
    #undef PK
  }
}

#ifndef ATTN_STORE16
#define ATTN_STORE16(p,v) (*(u32x4*)(p)=(v))
#endif
template<int THRL> __device__ __forceinline__ void attn_unit(int b,int h,int qb,const bf16*Q,const bf16*__restrict__ K,const bf16*__restrict__ V,bf16*O,char*shm,int csl_off){
  const int tid=tid_opaque(),lane=tid&63,r32=lane&31,hi=lane>>5; const int wid=__builtin_amdgcn_readfirstlane(tid>>6);
  const long rowbase=(long)b*SEQ; const int q0=qb*QB;
  const bf16*Qw=Q+(rowbase+q0+wid*QBLK)*DM+h*D;
  const bf16*Kh=K+rowbase*DM+h*D,*Vh=V+rowbase*DM+h*D;
  const unsigned lds0=(unsigned)(uintptr_t)shm;
  float*wsf=(float*)(shm+LDS_WS)+wid*64;
  const bf16*ksrc=Kh+(long)lane*DM+wid*8;
  const bf16*vsrc=Vh+(long)(16*(wid&3)+(lane>>2))*DM+(wid>>2)*32+(lane&3)*8;
  const unsigned kdst=lds0+LDS_K+wid*1024, vdst=lds0+LDS_V+wid*1024;
  #define DMA_K(t,slot) glds16(ksrc+(long)(t)*KVBLK*DM,(unsigned)__builtin_amdgcn_readfirstlane(kdst+(slot)))
  #define DMA_V(t,slot) glds16(vsrc+(long)(t)*KVBLK*DM,(unsigned)__builtin_amdgcn_readfirstlane(vdst+(slot)))
  const int vb0=(int)(lds0+LDS_V)+((lane>>4)&1)*32+(lane&3)*8+(4*hi+((lane&15)>>2))*64;
  const char*Kbase=shm+LDS_K; bf16x8 kf[8];
  const lds_cptr shm3=(lds_cptr)shm; const lds_cptr kp0=shm3+LDS_K+hi*1024+r32*16; const lds_cptr vp0=shm3+LDS_V+((lane>>4)&1)*32+(lane&3)*8+(4*hi+((lane&15)>>2))*64;
  const int NT=(q0+QB)/KVBLK;
  DMA_K(0,0);DMA_V(0,0);DMA_K(1,SLOTB);
  bf16x8 qr[4];
  #pragma unroll
  for(int d0=0;d0<4;++d0)qr[d0]=*reinterpret_cast<const bf16x8*>(&Qw[(long)r32*DM+d0*16+hi*8]);
  float mhat=0.f,l_reg=0.f;f32x16 o[2];o[0]=f32x16{};o[1]=f32x16{};
  typedef float f32x4_t __attribute__((ext_vector_type(4)));
  const __attribute__((address_space(3))) float* csl3=(const __attribute__((address_space(3))) float*)((lds_cptr)shm+csl_off);
  float nbase=csl3[q0+wid*QBLK+r32];
  #define BIASFILL(C0,C1,t) do{ const __attribute__((address_space(3))) float* cp_=csl3+(t)*KVBLK+4*hi; \
    _Pragma("unroll") for(int g_=0;g_<4;++g_){ const f32x4_t a_=*(const __attribute__((address_space(3))) f32x4_t*)(cp_+8*g_); const f32x4_t b_=*(const __attribute__((address_space(3))) f32x4_t*)(cp_+32+8*g_); \
      _Pragma("unroll") for(int e_=0;e_<4;++e_){ C0[4*g_+e_]=nbase-a_[e_]; C1[4*g_+e_]=nbase-b_[e_]; } } }while(0)
  const int qrel=wid*QBLK+r32;
  #define CMASK(P0,P1,t) do{int jb_=(t)-(NT-4); if(jb_>=0)cmask(P0,P1,jb_,qrel,hi);}while(0)
  bool resc=false;
  #define START(P0,P1) do{ const float rm=rowmax(P0,P1); resc=false; \
    { const float dl=rm; mhat=fadd_s(mhat,dl); \
      _Pragma("unroll") for(int r=0;r<16;++r){P0[r]=fsub_s(P0[r],dl);P1[r]=fsub_s(P1[r],dl);} \
      nbase=fsub_s(nbase,dl); } \
    _Pragma("unroll") for(int r=0;r<16;++r)P0[r]=__builtin_amdgcn_exp2f(P0[r]); }while(0)
  #define RESC() do{ if(resc){ asm volatile("s_waitcnt lgkmcnt(0)":::"memory"); \
      _Pragma("unroll") for(int d_=0;d_<2;++d_) _Pragma("unroll") for(int r=0;r<16;++r)o[d_][r]*=wsf[crow(r,hi)]; } }while(0)
  f32x16 pA0,pA1,pB0,pB1;
  int sl_prev=0,sl_cur=0,sl_next=SLOTB;
  #define ROT() do{sl_prev=sl_cur;sl_cur=sl_next;sl_next=(sl_next==(NSLOT-1)*SLOTB)?0:sl_next+SLOTB;}while(0)
  DMA_K(2,2*SLOTB);
  WAIT_BAR(3);
  BIASFILL(pA0,pA1,0);
  qkt(pA0,pA1,Kbase,qr,r32,hi);asm volatile("s_nop 15\n\ts_nop 7":"+v"(pA0),"+v"(pA1));CMASK(pA0,pA1,0);
  START(pA0,pA1);
  BIASFILL(pB0,pB1,1);
  _Pragma("unroll") for(int r=0;r<16;++r)pA1[r]=__builtin_amdgcn_exp2f(pA1[r]);
  WAIT_BAR(0);
  DMA_K(3,0);DMA_V(1,SLOTB);
  ROT();
  kload8(kf,kp0+sl_cur);
  WAIT_BAR(2);
  s16x4 vlo[8],vhi[8]; u32x4 pw0,pw1,pw2,pw3;
  #define PKW(P,B) cvtpk_s(P[B],P[B+1])
  #define PAF(k) __builtin_bit_cast(bf16x8,pw##k)
  #define VFR(i) (bf16x8){vlo[i][0],vlo[i][1],vlo[i][2],vlo[i][3],vhi[i][0],vhi[i][1],vhi[i][2],vhi[i][3]}
  #define PIN(x) asm volatile("":"+v"(x))
  #define MX3(a,b,c) __builtin_fmaxf(__builtin_fmaxf((a),(b)),(c))
  #define GAPA(MF,A0,A1,A2,A3,W0,W1,PW) do{ MF; sacc+=A0; sacc+=A1; sacc+=A2; sacc+=A3; PIN(sacc); W0; W1; PIN(PW); SBAR(); }while(0)
  #define EX(v) __builtin_amdgcn_exp2f(v)
  #define GAPB(MF,X,B) do{ MF; X[B]=EX(X[B]); X[B+1]=EX(X[B+1]); X[B+2]=EX(X[B+2]); X[B+3]=EX(X[B+3]); PIN(X); SBAR(); }while(0)
  #define VRD(i) do{ vlo[i]=vtr(vp_+(((i)>>2)*4096+((i)&3)*1024)); vhi[i]=vtr(vp_+(((i)>>2)*4096+((i)&3)*1024+512)); }while(0)
  #define KRD(G,j) do{ if(G){ kload2(kf,kp0+sl_next,j); SBAR(); } }while(0)
  #define STEP(C0,C1,P0,P1,t,GK,GV,GL) do{ SBAR(); \
    const lds_cptr vp_=vp0+sl_prev; \
    VRD(0); SBAR(); float sacc=(P0[0]+P0[1]); \
    GAPA(C0=__builtin_amdgcn_mfma_f32_32x32x16_bf16(kf[0],qr[0],C0,0,0,0), P0[2],P0[3],P0[4],P0[5],     pw0[0]=PKW(P0,0), pw0[1]=PKW(P0,2), pw0); \
    VRD(4); SBAR(); GAPA(C1=__builtin_amdgcn_mfma_f32_32x32x16_bf16(kf[1],qr[0],C1,0,0,0), P0[6],P0[7],P0[8],P0[9],     pw0[2]=PKW(P0,4), pw0[3]=PKW(P0,6), pw0); \
    VRD(1); SBAR(); GAPA(C0=__builtin_amdgcn_mfma_f32_32x32x16_bf16(kf[2],qr[1],C0,0,0,0),   P0[10],P0[11],P0[12],P0[13], pw1[0]=PKW(P0,8), pw1[1]=PKW(P0,10), pw1); \
    VRD(5); SBAR(); GAPA(C1=__builtin_amdgcn_mfma_f32_32x32x16_bf16(kf[3],qr[1],C1,0,0,0),   P0[14],P0[15],P1[0],P1[1],   pw1[2]=PKW(P0,12),pw1[3]=PKW(P0,14), pw1); \
    VRD(2); SBAR(); GAPA(C0=__builtin_amdgcn_mfma_f32_32x32x16_bf16(kf[4],qr[2],C0,0,0,0),   P1[2],P1[3],P1[4],P1[5],     pw2[0]=PKW(P1,0), pw2[1]=PKW(P1,2), pw2); \
    VRD(6); SBAR(); GAPA(C1=__builtin_amdgcn_mfma_f32_32x32x16_bf16(kf[5],qr[2],C1,0,0,0),   P1[6],P1[7],P1[8],P1[9],     pw2[2]=PKW(P1,4), pw2[3]=PKW(P1,6), pw2); \
    VRD(3); SBAR(); GAPA(C0=__builtin_amdgcn_mfma_f32_32x32x16_bf16(kf[6],qr[3],C0,0,0,0),   P1[10],P1[11],P1[12],P1[13], pw3[0]=PKW(P1,8), pw3[1]=PKW(P1,10), pw3); \
    VRD(7); SBAR(); GAPA(C1=__builtin_amdgcn_mfma_f32_32x32x16_bf16(kf[7],qr[3],C1,0,0,0),   P1[14],P1[15],0.f,0.f,       pw3[2]=PKW(P1,12),pw3[3]=PKW(P1,14), pw3); \
    l_reg+=sacc; \
    if(GK){DMA_K((t)+3,sl_cur);} if(GV){DMA_V((t)+1,sl_next);} \
    CMASK(C0,C1,t); \
    { float a=MX3(C0[0],C0[1],C1[0]),b=MX3(C0[2],C0[3],C1[1]); a=MX3(a,C1[2],C1[3]); \
      _Pragma("unroll") for(int r=4;r<16;r+=4){a=MX3(a,C0[r],C0[r+1]);b=MX3(b,C0[r+2],C0[r+3]);a=MX3(a,C1[r],C1[r+1]);b=MX3(b,C1[r+2],C1[r+3]);} \
      float rm=__builtin_fmaxf(a,b); { auto rr=__builtin_amdgcn_permlane32_swap(__float_as_uint(rm),__float_as_uint(rm),false,false); rm=__builtin_fmaxf(__uint_as_float(rr[0]),__uint_as_float(rr[1])); } \
      resc=false; \
      if(__builtin_expect(__any(rm>(float)THRL),0)){ const float dl=__builtin_fmaxf(rm,0.f); mhat+=dl; \
        _Pragma("unroll") for(int r=0;r<16;++r){C0[r]-=dl;C1[r]-=dl;} \
        nbase-=dl; \
        const float f=__builtin_amdgcn_exp2f(-dl); l_reg*=f; if(hi==0)wsf[r32]=f; resc=true; } } \
    SBAR(); \
    GAPB(o[0]=__builtin_amdgcn_mfma_f32_32x32x16_bf16(PAF(0),VFR(0),o[0],0,0,0), C0,0); \
    GAPB(o[1]=__builtin_amdgcn_mfma_f32_32x32x16_bf16(PAF(0),VFR(4),o[1],0,0,0), C0,4); \
    KRD(GL,0); GAPB(o[0]=__builtin_amdgcn_mfma_f32_32x32x16_bf16(PAF(1),VFR(1),o[0],0,0,0), C0,8); \
    KRD(GL,1); GAPB(o[1]=__builtin_amdgcn_mfma_f32_32x32x16_bf16(PAF(1),VFR(5),o[1],0,0,0), C0,12); \
    KRD(GL,2); GAPB(o[0]=__builtin_amdgcn_mfma_f32_32x32x16_bf16(PAF(2),VFR(2),o[0],0,0,0), C1,0); \
    KRD(GL,3); GAPB(o[1]=__builtin_amdgcn_mfma_f32_32x32x16_bf16(PAF(2),VFR(6),o[1],0,0,0), C1,4); \
    GAPB(o[0]=__builtin_amdgcn_mfma_f32_32x32x16_bf16(PAF(3),VFR(3),o[0],0,0,0), C1,8); \
    GAPB(o[1]=__builtin_amdgcn_mfma_f32_32x32x16_bf16(PAF(3),VFR(7),o[1],0,0,0), C1,12); \
    if(GV){ BIASFILL(P0,P1,(t)+1); } \
    }while(0)
  int t=1;
  #undef CMASK
  #define CMASK(P0,P1,t) do{}while(0)
  for(;t+5<NT;t+=2){
    STEP(pB0,pB1,pA0,pA1,t,true,true,true);     WAIT_BAR(2); RESC(); ROT();
    STEP(pA0,pA1,pB0,pB1,t+1,true,true,true);   WAIT_BAR(2); RESC(); ROT();
  }
  #undef CMASK
  #define CMASK(P0,P1,t) do{int jb_=(t)-(NT-4); if(jb_>=0)cmask(P0,P1,jb_,qrel,hi);}while(0)
  #define ENDW(tt) do{ if((tt)+3<NT){WAIT_BAR(2);} else if((tt)+2<NT){WAIT_BAR(1);} else {WAIT_BAR(0);} }while(0)
  for(;t+1<NT;t+=2){
    STEP(pB0,pB1,pA0,pA1,t,(t+3<NT),(t+1<NT),(t+1<NT));       ENDW(t);   RESC(); ROT();
    STEP(pA0,pA1,pB0,pB1,t+1,(t+4<NT),(t+2<NT),(t+2<NT));     ENDW(t+1); RESC(); ROT();
  }
  STEP(pB0,pB1,pA0,pA1,NT-1,false,false,false); RESC();
  { float sacc=pB0[0]+pB0[1]; _Pragma("unroll") for(int r=2;r<16;++r)sacc+=pB0[r]; _Pragma("unroll") for(int r=0;r<16;++r)sacc+=pB1[r]; l_reg+=sacc;
    pw0=(u32x4){PKW(pB0,0),PKW(pB0,2),PKW(pB0,4),PKW(pB0,6)};pw1=(u32x4){PKW(pB0,8),PKW(pB0,10),PKW(pB0,12),PKW(pB0,14)};pw2=(u32x4){PKW(pB1,0),PKW(pB1,2),PKW(pB1,4),PKW(pB1,6)};pw3=(u32x4){PKW(pB1,8),PKW(pB1,10),PKW(pB1,12),PKW(pB1,14)};
    SBAR(); pv(o,vb0+sl_cur,PAF(0),PAF(1),PAF(2),PAF(3)); }
  #undef PKW
  #undef PAF
  #undef VFR
  #undef PIN
  #undef MX3
  #undef GAPA
  #undef GAPB
  #undef EX
  #undef VRD
  #undef KRD
  #undef STEP
  #undef ENDW
  {auto rr=__builtin_amdgcn_permlane32_swap(__float_as_uint(l_reg),__float_as_uint(l_reg),false,false);l_reg=__uint_as_float(rr[0])+__uint_as_float(rr[1]);}
  if(hi==0)wsf[32+r32]=l_reg;asm volatile("s_waitcnt lgkmcnt(0)":::"memory");
  float rli[16];
  #pragma unroll
  for(int r=0;r<16;++r)rli[r]=__builtin_amdgcn_rcpf(wsf[32+crow(r,hi)]);
  bf16*Ow=O+(rowbase+q0+wid*QBLK)*DM+h*D;
  { bf16*stg=(bf16*)(shm+LDS_OST)+wid*2048;
    #pragma unroll
    for(int r=0;r<16;++r){const int orow=crow(r,hi);
      #pragma unroll
      for(int d0=0;d0<2;++d0)stg[orow*64+d0*32+r32]=__float2bfloat16(o[d0][r]*rli[r]);}
    asm volatile("s_waitcnt lgkmcnt(0)":::"memory");
    #pragma unroll
    for(int i=0;i<4;++i){const int row=i*8+(lane>>3),ch=lane&7; const u32x4 v=*(const u32x4*)(stg+row*64+ch*8); ATTN_STORE16(Ow+(long)row*DM+ch*8,v);} }
  asm volatile("s_waitcnt lgkmcnt(0)\n\ts_barrier":::"memory");
  #undef BIASFILL
  #undef DMA_K
  #undef DMA_V
  #undef CMASK
  #undef START
  #undef RESC
  #undef ROT
}
constexpr int ATTN_LDS_BYTES=LDS_BYTES;
struct AttnTensors { const bf16* Q; const bf16* K; const bf16* V; bf16* O; };
struct AttnUnit { int bh; int qb; };
struct StaticOrder {
  int vcu;
  __device__ __forceinline__ explicit StaticOrder(int grid,int block):vcu((block%8)*(grid/8)+block/8){}
  __device__ __forceinline__ bool next(int i,AttnUnit&u)const{ if(i>=4)return false; const int s=2*(vcu&1); u.bh=vcu>>1; u.qb=(i==0)?s:(i==1)?7-s:(i==2)?s+1:6-s; return true; }
  __device__ __forceinline__ void a_ready(const AttnUnit&)const{}
  __device__ __forceinline__ void done(const AttnUnit&)const{}
};
template<class Sched,int THRL=8> __device__ __forceinline__ void attn_phase(char*lds,const AttnTensors&T,const Sched&S,int csl_off){
  AttnUnit u;
  for(int i=0;S.next(i,u);++i){ S.a_ready(u); attn_unit<THRL>(u.bh/NHEAD,u.bh%NHEAD,u.qb,T.Q,T.K,T.V,T.O,lds,csl_off); S.done(u); }
}
#undef SBAR
#undef WAIT_BAR
}

#define GAS __attribute__((address_space(1)))
#define LAS __attribute__((address_space(3)))
typedef unsigned v4u __attribute__((ext_vector_type(4)));
typedef GAS unsigned gu32;
typedef GAS unsigned long long gu64;
#define RLX_AGENT __ATOMIC_RELAXED, __HIP_MEMORY_SCOPE_AGENT
#define LDS_WAIT() asm volatile("s_waitcnt lgkmcnt(0)" ::: "memory")
#define VM_WAIT() asm volatile("s_waitcnt vmcnt(0)" ::: "memory")
__device__ __forceinline__ unsigned long long rt() { return __builtin_amdgcn_s_memrealtime(); }

#define XB_TMO      128
#define XB_XCNT(j)  (256  + 64 * (j))
#define XB_XSUB(j)  (1280 + 64 * (j))
#define XB_XGEN(j)  (2304 + 64 * (j))
#define XB_TOP      3328
#define XB_TOPGEN   3392
#define XCD_BAR_WORDS 3456
#define XB_SPIN_CAP (1u << 18)

__device__ __forceinline__ unsigned xb_ld(unsigned* p)              { return __hip_atomic_load(p, __ATOMIC_RELAXED, __HIP_MEMORY_SCOPE_AGENT); }
__device__ __forceinline__ unsigned xb_add(unsigned* p, unsigned v) { return __hip_atomic_fetch_add(p, v, __ATOMIC_RELAXED, __HIP_MEMORY_SCOPE_AGENT); }
__device__ __forceinline__ unsigned xb_xcc_id() { return (unsigned)__builtin_amdgcn_s_getreg((3 << 11) | 20) & 0xFu; }
#define XB_SPIN(cond, bar) do { unsigned _sp = 0; while (cond) { __builtin_amdgcn_s_sleep(1); \
    if ((++_sp & 255u) == 0u) { if (xb_ld(&(bar)[XB_TMO])) break; if (_sp > XB_SPIN_CAP) { atomicAdd(&(bar)[XB_TMO], 1u); break; } } } } while (0)

struct XcdBarrier {
    unsigned* bar; unsigned x;
    volatile LAS unsigned* st;
};

__device__ __forceinline__ XcdBarrier xcd_barrier_post(unsigned* bar, volatile LAS unsigned* st) {
    XcdBarrier b; b.bar = bar; b.x = xb_xcc_id(); b.st = st;
    if (threadIdx.x == 0) (void)xb_add(&bar[XB_XCNT(b.x)], 1u);
    return b;
}
__device__ __forceinline__ void xcd_barrier_complete(unsigned* bar, unsigned x, unsigned& nloc, unsigned& nx) {
    const unsigned G = gridDim.x * gridDim.y * gridDim.z;
    unsigned sum, cnt, mine, sp = 0u;
    for (;;) {
        sum = 0u; cnt = 0u; mine = 0u;
#pragma unroll
        for (unsigned j = 0; j < 16; ++j) { const unsigned c = xb_ld(&bar[XB_XCNT(j)]); sum += c; cnt += (c > 0u) ? 1u : 0u; mine = (j == x) ? c : mine; }
        if (sum == G) break;
        __builtin_amdgcn_s_sleep(1);
        if ((++sp & 255u) == 0u) { if (xb_ld(&bar[XB_TMO])) break; if (sp > XB_SPIN_CAP) { atomicAdd(&bar[XB_TMO], 1u); break; } }
    }
    nloc = mine > 0u ? mine : 1u; nx = cnt > 0u ? cnt : 1u;
}

__device__ __forceinline__ void xcd_barrier(const XcdBarrier& b) {
    asm volatile("s_waitcnt vmcnt(0)" ::: "memory");
    __syncthreads();
    if (threadIdx.x == 0) {
        unsigned* bar = b.bar;
        __builtin_amdgcn_s_waitcnt(0);
        unsigned nloc = b.st[0], nx = b.st[1];
        if (nloc == 0u) { xcd_barrier_complete(bar, b.x, nloc, nx); b.st[0] = nloc; b.st[1] = nx; }
        const unsigned old = xb_add(&bar[XB_XSUB(b.x)], 1u);
        const unsigned gen = old / nloc;
        if (old + 1u == (gen + 1u) * nloc) {
            __builtin_amdgcn_fence(__ATOMIC_RELEASE, "agent");
            asm volatile("s_waitcnt vmcnt(0)" ::: "memory");
            const unsigned og = xb_add(&bar[XB_TOP], 1u);
            const unsigned tg = og / nx;
            if (og + 1u == (tg + 1u) * nx) xb_add(&bar[XB_TOPGEN], 1u);
            else XB_SPIN(xb_ld(&bar[XB_TOPGEN]) == tg, bar);
            __builtin_amdgcn_fence(__ATOMIC_ACQUIRE, "agent");
            xb_add(&bar[XB_XGEN(b.x)], 1u);
            asm volatile("s_waitcnt vmcnt(0)" ::: "memory");
        } else {
            XB_SPIN(xb_ld(&bar[XB_XGEN(b.x)]) == gen, bar);
            __builtin_amdgcn_fence(__ATOMIC_ACQUIRE, "agent");
            asm volatile("s_waitcnt vmcnt(0)" ::: "memory");
        }
    }
    __syncthreads();
}


typedef float f32x16 __attribute__((ext_vector_type(16)));
struct WgFrag { bf16x8 a[4], b[4]; };
__device__ __forceinline__ void wg_load(WgFrag& f, const char* ap, const char* bp, int batch) {
#pragma unroll
    for (int s = 0; s < 4; ++s) { f.a[s] = *(const bf16x8*)(ap + 128 * batch + 16 * s); f.b[s] = *(const bf16x8*)(bp + 128 * batch + 16 * s); }
}
__device__ __forceinline__ void wg_mma(f32x16& acc, const WgFrag& f) {
#pragma unroll
    for (int s = 0; s < 4; ++s) acc = __builtin_amdgcn_mfma_f32_32x32x16_bf16(f.b[s], f.a[s], acc, 0, 0, 0);
}
__device__ __forceinline__ void wave_gemm32(f32x16& acc, const bf16_t* A, int lda, int row0, const bf16_t* Bt, int ldb, int col0, int ncolvalid, int k0, int klen, int lane) {
    const int r = lane & 31, hi = lane >> 5, rb = r < ncolvalid ? r : r % ncolvalid;
    const char* ap = (const char*)(A + (size_t)(row0 + r) * lda + k0) + 64 * hi;
    const char* bp = (const char*)(Bt + (size_t)(col0 + rb) * ldb + k0) + 64 * hi;
    int nB = klen / 64; asm volatile("" : "+s"(nB));
    WgFrag X, Y, Z;
    wg_load(X, ap, bp, 0); wg_load(Y, ap, bp, 1);
#pragma unroll 1
    for (int S = 0; S < nB; S += 3) {
        if (S + 2 < nB) wg_load(Z, ap, bp, S + 2);
        wg_mma(acc, X);
        if (S + 3 < nB) wg_load(X, ap, bp, S + 3);
        if (S + 1 < nB) wg_mma(acc, Y);
        if (S + 4 < nB) wg_load(Y, ap, bp, S + 4);
        if (S + 2 < nB) wg_mma(acc, Z);
    }
}
template <class F> __device__ __forceinline__ void wave_epi32(const f32x16& acc, int row0, int col0, int lane, const F& f) {
    const int r = lane & 31, hi = lane >> 5;
#pragma unroll
    for (int g = 0; g < 4; ++g) f(row0 + r, col0 + 8 * g + 4 * hi, (f32x4){acc[4 * g], acc[4 * g + 1], acc[4 * g + 2], acc[4 * g + 3]});
}

constexpr int NWAVES = 8;
constexpr int RING_OFF = 0, RING_BYTES = 131072;
constexpr int LDS_CSL = 86016;
constexpr int LDSCTL_OFF = RING_BYTES, MISC_OFF = LDSCTL_OFF + 320;
constexpr int LDS_BYTES = 147456;
static_assert(attn_body::ATTN_LDS_BYTES <= LDS_CSL && LDS_CSL + NKEY * 4 <= RING_BYTES, "LDS map");
constexpr int CW_BAR = 1024;
constexpr size_t CTL_ZERO_BYTES = 65536;
static_assert((CW_BAR + XCD_BAR_WORDS) * 4 <= (int)CTL_ZERO_BYTES, "ctl");

template <class F> struct EpiElem {
    static constexpr bool PERM = false, AFTER_DRAIN = false; F f;
    __device__ __forceinline__ void operator()(const f32x4 (&acc)[2][2][4][2], const pg8::Unit& u, int wr, int wc, int fr, int fq) const {
        const int row0 = u.pm * 256 + wr * 64 + fr, col0 = u.pn * 256 + wc * 32 + 4 * fq;
#pragma unroll
        for (int ai = 0; ai < 2; ++ai)
#pragma unroll
            for (int m = 0; m < 4; ++m)
#pragma unroll
                for (int bj = 0; bj < 2; ++bj)
#pragma unroll
                    for (int n = 0; n < 2; ++n) f(row0 + ai * 128 + m * 16, col0 + bj * 128 + n * 16, acc[ai][bj][m][n]);
    }
};

template <class F> struct EpiElem8 {
    static constexpr bool PERM = true, AFTER_DRAIN = false; F f;
    __device__ __forceinline__ void operator()(const f32x4 (&acc)[2][2][4][2], const pg8::Unit& u, int wr, int wc, int fr, int fq) const {
        const int row0 = u.pm * 256 + wr * 64 + fr, col0 = u.pn * 256 + wc * 32 + 8 * fq;
#pragma unroll
        for (int ai = 0; ai < 2; ++ai)
#pragma unroll
            for (int m = 0; m < 4; ++m)
#pragma unroll
                for (int bj = 0; bj < 2; ++bj) f.op8(row0 + ai * 128 + m * 16, col0 + bj * 128, acc[ai][bj][m][0], acc[ai][bj][m][1]);
    }
};

template <int PER, class Ld> __device__ __forceinline__ void block_cumsum_lds(float* csl, float* wtot, int npos, const Ld& ld) {
    const int tid = tid_opaque(), lane = tid & 63, wave = tid >> 6;
    float v[PER]; float run = 0.f;
#pragma unroll
    for (int e = 0; e < PER; ++e) { const int pos = tid * PER + e; v[e] = pos < npos ? ld(pos) : 0.f; run += v[e]; v[e] = run; }
    const float incl = wave_incl_scan(run, lane), excl = incl - run;
    if (lane == 63) wtot[wave] = incl;
    __syncthreads();
    float off = excl;
#pragma unroll
    for (int w = 0; w < 8; ++w) if (w < wave) off += wtot[w];
#pragma unroll
    for (int e = 0; e < PER; ++e) { const int pos = tid * PER + e; if (pos < npos) csl[pos] = (off + v[e]) * LOG2E; }
    __syncthreads();
}

template <int W> __device__ __forceinline__ void pool_seg16(const Params& p, int row0, int c0) {
    const bf16_t* U = (const bf16_t*)(p.ws + WS_U); bf16_t* PO = (bf16_t*)(p.ws + WS_PO);
    const int t0 = row0 % SEQ;
    u32x4 v[W - 1 + 16];
#pragma unroll
    for (int j = 0; j < W - 1 + 16; ++j) { const int r = j - (W - 1); v[j] = (t0 + r >= 0) ? *(const u32x4*)(U + (size_t)(row0 + r) * PW + c0) : (u32x4){0u, 0u, 0u, 0u}; }
    float s[8];
#pragma unroll
    for (int e = 0; e < 8; ++e) s[e] = 0.f;
#pragma unroll
    for (int j = 0; j < W - 1; ++j) { s[0] += bflo(v[j].x); s[1] += bfhi(v[j].x); s[2] += bflo(v[j].y); s[3] += bfhi(v[j].y); s[4] += bflo(v[j].z); s[5] += bfhi(v[j].z); s[6] += bflo(v[j].w); s[7] += bfhi(v[j].w); }
#pragma unroll
    for (int r = 0; r < 16; ++r) { const u32x4 c = v[r + W - 1], q = v[r]; const int t = t0 + r;
        const float cur[8] = {bflo(c.x), bfhi(c.x), bflo(c.y), bfhi(c.y), bflo(c.z), bfhi(c.z), bflo(c.w), bfhi(c.w)};
        const float old[8] = {bflo(q.x), bfhi(q.x), bflo(q.y), bfhi(q.y), bflo(q.z), bfhi(q.z), bflo(q.w), bfhi(q.w)};
        const float rc = 1.0f / (float)((t + 1 < W) ? t + 1 : W); float o[8];
#pragma unroll
        for (int e = 0; e < 8; ++e) { s[e] += cur[e]; o[e] = s[e] * rc - cur[e]; s[e] -= old[e]; }
        u32x4 ov; ov.x = pk2(o[0], o[1]); ov.y = pk2(o[2], o[3]); ov.z = pk2(o[4], o[5]); ov.w = pk2(o[6], o[7]);
        *(u32x4*)(PO + (size_t)(row0 + r) * PW + c0) = ov; }
}

struct SaKV { f32x4 k[8]; float v[32]; };
__device__ __forceinline__ void sa_load(SaKV& f, const float* kp, const float* vp, int key0) {
#pragma unroll
    for (int bl = 0; bl < 2; ++bl)
#pragma unroll
        for (int ks = 0; ks < 2; ++ks)
#pragma unroll
            for (int hf = 0; hf < 2; ++hf) f.k[(bl * 2 + ks) * 2 + hf] = *(const f32x4*)(kp + (size_t)(key0 + 16 * bl) * (NH * DH) + 32 * ks + 4 * hf);
#pragma unroll
    for (int db = 0; db < 4; ++db)
#pragma unroll
        for (int j = 0; j < 8; ++j) f.v[db * 8 + j] = vp[(size_t)(key0 + (j < 4 ? j : 12 + j)) * (NH * DH) + 16 * db];
}
__device__ __forceinline__ bf16x8 pack8(float a0, float a1, float a2, float a3, float a4, float a5, float a6, float a7) {
    u32x4 w; w.x = pk2(a0, a1); w.y = pk2(a2, a3); w.z = pk2(a4, a5); w.w = pk2(a6, a7); return __builtin_bit_cast(bf16x8, w);
}
__device__ __forceinline__ void sa_step(const SaKV& f, const bf16x8 (&qf)[2], const float* csl, int key0, float ct, int g, float& m, float& l, f32x4 (&o)[4]) {
    f32x4 s[2];
#pragma unroll
    for (int bl = 0; bl < 2; ++bl) { const f32x4 cs = *(const f32x4*)(csl + key0 + 16 * bl + 4 * g); s[bl] = (f32x4){ct - cs.x, ct - cs.y, ct - cs.z, ct - cs.w};
#pragma unroll
        for (int ks = 0; ks < 2; ++ks) { const f32x4 a = f.k[(bl * 2 + ks) * 2], c = f.k[(bl * 2 + ks) * 2 + 1];
            s[bl] = __builtin_amdgcn_mfma_f32_16x16x32_bf16(pack8(a.x, a.y, a.z, a.w, c.x, c.y, c.z, c.w), qf[ks], s[bl], 0, 0, 0); } }
    float mx = fmaxf(fmaxf(fmaxf(s[0].x, s[0].y), fmaxf(s[0].z, s[0].w)), fmaxf(fmaxf(s[1].x, s[1].y), fmaxf(s[1].z, s[1].w)));
    mx = fmaxf(mx, __shfl_xor(mx, 16)); mx = fmaxf(mx, __shfl_xor(mx, 32));
    const float mn = fmaxf(m, mx), alpha = exp2f(m - mn); m = mn;
    float pr[8];
#pragma unroll
    for (int e = 0; e < 4; ++e) { pr[e] = exp2f(s[0][e] - mn); pr[4 + e] = exp2f(s[1][e] - mn); }
    l = l * alpha + ((pr[0] + pr[1]) + (pr[2] + pr[3])) + ((pr[4] + pr[5]) + (pr[6] + pr[7]));
    const bf16x8 pf = pack8(pr[0], pr[1], pr[2], pr[3], pr[4], pr[5], pr[6], pr[7]);
#pragma unroll
    for (int db = 0; db < 4; ++db) { o[db] = o[db] * alpha;
        o[db] = __builtin_amdgcn_mfma_f32_16x16x32_bf16(pack8(f.v[db * 8], f.v[db * 8 + 1], f.v[db * 8 + 2], f.v[db * 8 + 3], f.v[db * 8 + 4], f.v[db * 8 + 5], f.v[db * 8 + 6], f.v[db * 8 + 7]), pf, o[db], 0, 0, 0); }
}
__device__ __forceinline__ void sample_attn(const Params& p, int bh, const float* csl, float* part, bf16_t* AO) {
    const int tid = tid_opaque(), lane = tid & 63, wave = __builtin_amdgcn_readfirstlane(tid >> 6), i = lane & 15, g = lane >> 4, b = bh / NH, h = bh % NH;
    const bf16_t* Q = (const bf16_t*)(p.ws + WS_Q); const bf16_t* Kb = (const bf16_t*)(p.ws + WS_K); const bf16_t* Vb = (const bf16_t*)(p.ws + WS_V);
    bf16x8 qf[2];
#pragma unroll
    for (int ks = 0; ks < 2; ++ks) qf[ks] = *(const bf16x8*)(Q + (size_t)(MP + b * SN + i) * AW + h * DH + 32 * ks + 8 * g);
    const float ct = csl[PAST + i]; float m = -INFINITY, l = 0.f; f32x4 o[4];
#pragma unroll
    for (int db = 0; db < 4; ++db) o[db] = (f32x4){0.f, 0.f, 0.f, 0.f};
    const float* kp = p.ck + (((size_t)b * PAST + i) * NH + h) * DH + 8 * g;
    const float* vp = p.cv + (((size_t)b * PAST + 4 * g) * NH + h) * DH + i;
    const int k0 = wave * 256;
    SaKV X, Y;
    sa_load(X, kp, vp, k0);
#pragma unroll 1
    for (int st = 0; st < 8; st += 2) {
        sa_load(Y, kp, vp, k0 + 32 * (st + 1));
        sa_step(X, qf, csl, k0 + 32 * st, ct, g, m, l, o);
        if (st + 2 < 8) sa_load(X, kp, vp, k0 + 32 * (st + 2));
        sa_step(Y, qf, csl, k0 + 32 * (st + 1), ct, g, m, l, o);
    }
    if (wave == 7) {
        const int r0 = MP + b * SN;
        f32x4 s; { const f32x4 cs = *(const f32x4*)(csl + PAST + 4 * g); s = (f32x4){ct - cs.x, ct - cs.y, ct - cs.z, ct - cs.w}; }
#pragma unroll
        for (int ks = 0; ks < 2; ++ks) s = __builtin_amdgcn_mfma_f32_16x16x32_bf16(*(const bf16x8*)(Kb + (size_t)(r0 + i) * AW + h * DH + 32 * ks + 8 * g), qf[ks], s, 0, 0, 0);
#pragma unroll
        for (int e = 0; e < 4; ++e) if (4 * g + e > i) s[e] = -INFINITY;
        float mx = fmaxf(fmaxf(s.x, s.y), fmaxf(s.z, s.w));
        mx = fmaxf(mx, __shfl_xor(mx, 16)); mx = fmaxf(mx, __shfl_xor(mx, 32));
        const float mn = fmaxf(m, mx), alpha = exp2f(m - mn); m = mn;
        float pr[4];
#pragma unroll
        for (int e = 0; e < 4; ++e) pr[e] = exp2f(s[e] - mn);
        l = l * alpha + ((pr[0] + pr[1]) + (pr[2] + pr[3]));
        const bf16x8 pf = pack8(pr[0], pr[1], pr[2], pr[3], 0.f, 0.f, 0.f, 0.f);
#pragma unroll
        for (int db = 0; db < 4; ++db) { float vv[4];
#pragma unroll
            for (int j = 0; j < 4; ++j) vv[j] = bf2f(Vb[(size_t)(r0 + 4 * g + j) * AW + h * DH + 16 * db + i]);
            o[db] = o[db] * alpha;
            o[db] = __builtin_amdgcn_mfma_f32_16x16x32_bf16(pack8(vv[0], vv[1], vv[2], vv[3], 0.f, 0.f, 0.f, 0.f), pf, o[db], 0, 0, 0); }
    }
    l += __shfl_xor(l, 16); l += __shfl_xor(l, 32);
    float* my = part + (wave * 16 + i) * 66;
#pragma unroll
    for (int db = 0; db < 4; ++db)
#pragma unroll
        for (int e = 0; e < 4; ++e) my[16 * db + 4 * g + e] = o[db][e];
    if (g == 0) { my[64] = m; my[65] = l; }
    __syncthreads();
    { const int i2 = tid & 15, dg = tid >> 4;
        float M = -INFINITY;
#pragma unroll
        for (int w = 0; w < 8; ++w) M = fmaxf(M, part[(w * 16 + i2) * 66 + 64]);
        float L = 0.f, a0 = 0.f, a1 = 0.f;
#pragma unroll
        for (int w = 0; w < 8; ++w) { const float* pw_ = part + (w * 16 + i2) * 66; const float f = exp2f(pw_[64] - M); L += f * pw_[65]; a0 += f * pw_[2 * dg]; a1 += f * pw_[2 * dg + 1]; }
        const float rl = 1.f / L;
        *(unsigned*)(AO + (size_t)(MP + b * SN + i2) * AW + h * DH + 2 * dg) = pk2(a0 * rl, a1 * rl);
    }
    __syncthreads();
}

#ifndef PROBE_MASK
#define PROBE_MASK 0
#endif
__global__ void __launch_bounds__(NWAVES * 64, 2) mega_fwd(Params p) {
    extern __shared__ __attribute__((aligned(16))) unsigned char lds[];
    LAS unsigned char* ldsl = (LAS unsigned char*)lds;
    volatile LAS unsigned* MISC = (volatile LAS unsigned*)(ldsl + MISC_OFF);
    const int G = gridDim.x, bx = blockIdx.x, vcu = (G % 8 == 0) ? (bx % 8) * (G / 8) + bx / 8 : bx;
    gu32* ctl = (gu32*)(p.ws + WS_CTL);
    for (int u = threadIdx.x; u < (LDS_BYTES - LDSCTL_OFF) / 4; u += NWAVES * 64) ((LAS unsigned*)(ldsl + LDSCTL_OFF))[u] = 0u;
    __syncthreads();
    const bool one = (p.ph_hi - p.ph_lo) > 1;
    XcdBarrier bar; bar.bar = (unsigned*)(ctl + CW_BAR); bar.x = 0; bar.st = nullptr;
    if (one) bar = xcd_barrier_post((unsigned*)(ctl + CW_BAR), MISC + 8);
    const int lo = p.ph_lo, hi = p.ph_hi;
#define IN(k) (lo <= (k) && (k) < hi)
#define SEAM(k) do { if (IN(k) && IN((k) + 1)) xcd_barrier(bar); } while (0)
    const int NGW = G * NWAVES;
#define PHASE_IDS const int tid = tid_opaque(), lane = tid & 63, wave = __builtin_amdgcn_readfirstlane(tid >> 6), gw = vcu * NWAVES + wave; (void)lane; (void)gw; (void)tid
    bf16_t* H = (bf16_t*)(p.ws + WS_H);

    if (IN(0)) for (int prep = 0; prep < 1 + ((PROBE_MASK >> 0) & 1); ++prep) { PHASE_IDS; if (prep) xcd_barrier(bar);
        convert_weights(p, (float*)(lds + wave * 16384), gw, NGW, lane);
        for (int row = gw; row < R; row += NGW) rms_row_to_bf16(xrow(p, row), p.g_pre, H + (size_t)row * D, lane);
    }
    SEAM(0);
    if (IN(1)) for (int prep = 0; prep < 1 + ((PROBE_MASK >> 1) & 1); ++prep) { PHASE_IDS; if (prep) xcd_barrier(bar);
        const EpiIn EI{(bf16_t*)(p.ws + WS_Q), (bf16_t*)(p.ws + WS_K), (bf16_t*)(p.ws + WS_V), (bf16_t*)(p.ws + WS_U), (bf16_t*)(p.ws + WS_SA), (bf16_t*)(p.ws + WS_SB), p.out, p.pscale};
        for (int u = bx; u < NMAIN / 32; u += G) { f32x16 acc = {};
            wave_gemm32(acc, H, D, MP + 32 * wave, (const bf16_t*)(p.ws + WS_WIN), D, 32 * u, 32, 0, D, lane);
            wave_epi32(acc, MP + 32 * wave, 32 * u, lane, EI); }
        for (int ub = 2 * bx; ub < R / 32; ub += 2 * G) { const int blk = ub + (wave >> 2), ks = wave & 3; f32x16 acc = {};
            if (blk < R / 32) wave_gemm32(acc, H, D, 32 * blk, (const bf16_t*)(p.ws + WS_WIN) + (size_t)NMAIN * D, D, 0, 16, 512 * ks, 512, lane);
            float* red = (float*)lds;
            { const int r = lane & 31, hh = lane >> 5;
#pragma unroll
              for (int g2 = 0; g2 < 2; ++g2)
#pragma unroll
                for (int e = 0; e < 4; ++e) red[(wave * 32 + r) * 16 + 8 * g2 + 4 * hh + e] = acc[4 * g2 + e]; }
            __syncthreads();
            if (tid < 256) { const int u2 = tid >> 7, rr = (tid >> 2) & 31, c4 = (tid & 3) * 4, blk2 = ub + u2;
                if (blk2 < R / 32) { f32x4 v = {0.f, 0.f, 0.f, 0.f};
#pragma unroll
                    for (int k4 = 0; k4 < 4; ++k4) v += *(const f32x4*)(red + ((u2 * 4 + k4) * 32 + rr) * 16 + c4);
                    EpiLogf EL{(float*)(p.ws + WS_LOGF), p.out, p.b_f}; EL(32 * blk2 + rr, c4, v); } }
            __syncthreads(); }
        pg8::Gemm g{H, (const bf16_t*)(p.ws + WS_WIN), MP, NMAIN, D, D, 0}; pg8::StaticOrder S; S.init(MP, NMAIN, G, bx);
        EpiElem8<EpiIn> E{EI};
        pg8::gemm_phase<EpiElem8<EpiIn>, pg8::StaticOrder, true, true>(ldsl + RING_OFF, g, S, E);
    }
    SEAM(1);
    if (IN(2)) for (int prep = 0; prep < 1 + ((PROBE_MASK >> 2) & 1); ++prep) { PHASE_IDS; if (prep) xcd_barrier(bar);
        float* csl = (float*)(lds + LDS_CSL); float* wtot = (float*)(lds + LDS_CSL + 8320);
        const float* LOGF = (const float*)(p.ws + WS_LOGF);
        const attn_body::StaticOrder S(G, bx);
        { const int bh = S.vcu >> 1, b = bh / NH, h = bh % NH;
          block_cumsum_lds<4>(csl, wtot, SEQ, [&](int pos) { return LOGF[((size_t)b * SEQ + pos) * NH + h]; }); }
        const attn_body::AttnTensors AT{(const attn_body::bf16*)(p.ws + WS_Q), (const attn_body::bf16*)(p.ws + WS_K), (const attn_body::bf16*)(p.ws + WS_V), (attn_body::bf16*)(p.ws + ((((PROBE_MASK >> 2) & 1) && prep == 0) ? WS_TM : WS_Q))};
        if ((PROBE_MASK >> 9) & 1) { const attn_body::AttnTensors AT2{AT.Q, AT.K, AT.V, (attn_body::bf16*)(p.ws + WS_TM)}; attn_body::attn_phase<attn_body::StaticOrder>((char*)lds + RING_OFF, AT2, S, LDS_CSL); }
        attn_body::attn_phase<attn_body::StaticOrder>((char*)lds + RING_OFF, AT, S, LDS_CSL);
        for (int prep2 = 0; prep2 < 1 + ((PROBE_MASK >> 10) & 1); ++prep2) { const int gwv = bx * NWAVES + wave;
          for (int it = gwv; it < (MP / 32) * 4; it += G * NWAVES) { const int g = it & 3, row0 = (it >> 2) * 32 + (lane >> 5) * 16, c0 = g * 256 + (lane & 31) * 8;
              if (g == 0) pool_seg16<2>(p, row0, c0); else if (g == 1) pool_seg16<4>(p, row0, c0); else if (g == 2) pool_seg16<8>(p, row0, c0); else pool_seg16<16>(p, row0, c0); }
          const int gt = bx * (NWAVES * 64) + tid;
          for (int it = gt; it < MS * (PW / 8); it += G * NWAVES * 64) pool_chunk(p, MP + it / (PW / 8), it % (PW / 8)); }
        for (int bh = bx; bh < SB_ * NH; bh += G) { const int b = bh / NH, h = bh % NH;
            __syncthreads();
            block_cumsum_lds<5>(csl, wtot, NKEY, [&](int pos) { return pos < PAST ? p.clf[((size_t)b * PAST + pos) * NH + h] : LOGF[((size_t)MP + b * SN + (pos - PAST)) * NH + h]; });
            if ((PROBE_MASK >> 11) & 1) sample_attn(p, bh, csl, (float*)lds, (bf16_t*)(p.ws + WS_TM));
            sample_attn(p, bh, csl, (float*)lds, (bf16_t*)(p.ws + ((((PROBE_MASK >> 2) & 1) && prep == 0) ? WS_TM : WS_Q))); }
    }
    SEAM(2);
    if (IN(3)) for (int prep = 0; prep < 1 + ((PROBE_MASK >> 3) & 1); ++prep) { PHASE_IDS; if (prep) xcd_barrier(bar);
        const EpiPool EP{(const bf16_t*)(p.ws + WS_SB), (bf16_t*)(p.ws + WS_TM)}; const EpiUp EU{(const bf16_t*)(p.ws + WS_SA), (bf16_t*)(p.ws + WS_TM)};
        for (int wu = gw; wu < (MS / 32) * (D / 32); wu += NGW) { const int rb = wu >> 6, cb = wu & 63, row0 = MP + 32 * rb, col0 = 32 * cb;
            f32x16 a1 = {}, a2 = {};
            wave_gemm32(a1, (const bf16_t*)(p.ws + WS_PO) + (cb >> 4) * 256, PW, row0, (const bf16_t*)(p.ws + WS_WPOOL), 256, col0, 32, 0, 256, lane);
            wave_gemm32(a2, (const bf16_t*)(p.ws + WS_Q), AW, row0, (const bf16_t*)(p.ws + WS_WUP), AW, col0, 32, 0, AW, lane);
            const int r = lane & 31, hh = lane >> 5;
#pragma unroll
            for (int g2 = 0; g2 < 4; ++g2) { const size_t off = (size_t)(row0 + r) * D + col0 + 8 * g2 + 4 * hh;
                const f32x4 sb = ld_bf16x4(EP.SB + off), sa = ld_bf16x4(EU.SA + off);
                const f32x4 t = (f32x4){a1[4 * g2], a1[4 * g2 + 1], a1[4 * g2 + 2], a1[4 * g2 + 3]} * sb, u2 = (f32x4){a2[4 * g2], a2[4 * g2 + 1], a2[4 * g2 + 2], a2[4 * g2 + 3]};
                st_bf16x4(EU.T + off, u2 * sa + t); } }
        { int kpool = 256; asm volatile("" : "+s"(kpool));
          pg8::Gemm g{(const bf16_t*)(p.ws + WS_PO), (const bf16_t*)(p.ws + WS_WPOOL), MP, D, kpool, PW, 256}; pg8::StaticOrder S; S.init(MP, D, G, bx);
          EpiElem8<EpiPool> E{EP};
          pg8::gemm_phase<EpiElem8<EpiPool>, pg8::StaticOrder, true, true>(ldsl + RING_OFF, g, S, E); }
        __syncthreads();
        { pg8::Gemm g{(const bf16_t*)(p.ws + WS_Q), (const bf16_t*)(p.ws + WS_WUP), MP, D, AW, AW, 0}; pg8::StaticOrder S; S.init(MP, D, G, bx);
          EpiElem8<EpiUp> E{EU};
          pg8::gemm_phase<EpiElem8<EpiUp>, pg8::StaticOrder, true, true>(ldsl + RING_OFF, g, S, E); }
    }
    SEAM(3);
    if (IN(4)) for (int prep = 0; prep < 1 + ((PROBE_MASK >> 4) & 1); ++prep) { PHASE_IDS; if (prep) xcd_barrier(bar);
        for (int wu = gw; wu < (MS / 32) * (D / 32) * 4; wu += NGW) { const int ks = wu & 3, cb = (wu >> 2) & 63, rb = wu >> 8; f32x16 acc = {};
            wave_gemm32(acc, (const bf16_t*)(p.ws + WS_TM), D, MP + 32 * rb, (const bf16_t*)(p.ws + WS_WOUT), D, 32 * cb, 32, 512 * ks, 512, lane);
            wave_epi32(acc, 32 * rb, 32 * cb, lane, EpiF32{(float*)(p.ws + WS_SLAB) + (size_t)ks * MS * D, D}); }
        pg8::Gemm g{(const bf16_t*)(p.ws + WS_TM), (const bf16_t*)(p.ws + WS_WOUT), MP, D, D, D, 0}; pg8::StaticOrder S; S.init(MP, D, G, bx);
        EpiElem<EpiF32> E{EpiF32{(float*)(p.ws + WS_MO), D}};
        pg8::gemm_phase<EpiElem<EpiF32>, pg8::StaticOrder, true, true>(ldsl + RING_OFF, g, S, E);
    }
    SEAM(4);
    if (IN(5)) for (int prep = 0; prep < 1 + ((PROBE_MASK >> 5) & 1); ++prep) { PHASE_IDS; if (prep) xcd_barrier(bar);
        const float* MO = (const float*)(p.ws + WS_MO);
        for (int row = gw; row < R; row += NGW) {
            const f32x4* mr = (const f32x4*)(MO + (size_t)row * D) + lane; const f32x4* xr = (const f32x4*)xrow(p, row) + lane;
            const f32x4* g1 = (const f32x4*)p.g_post + lane; const f32x4* g2 = (const f32x4*)p.g_ffn_pre + lane;
            f32x4 v[8]; float s = 0.f;
#pragma unroll
            for (int j = 0; j < 8; ++j) { if (row < MP) v[j] = mr[64 * j]; else { const f32x4* sl = (const f32x4*)((const float*)(p.ws + WS_SLAB) + (size_t)(row - MP) * D) + lane + 64 * j; v[j] = (sl[0] + sl[MS * D / 4]) + (sl[2 * (MS * D / 4)] + sl[3 * (MS * D / 4)]); }
                s += (v[j].x * v[j].x + v[j].y * v[j].y) + (v[j].z * v[j].z + v[j].w * v[j].w); }
            const float r1 = rsqrtf(wave_sum(s) * (1.f / D) + EPS); float s2 = 0.f;
            f32x4* orow = (f32x4*)(p.out + O_Y + (size_t)row * D) + lane;
#pragma unroll
            for (int j = 0; j < 8; ++j) { v[j] = xr[64 * j] + v[j] * r1 * g1[64 * j]; orow[64 * j] = v[j]; s2 += (v[j].x * v[j].x + v[j].y * v[j].y) + (v[j].z * v[j].z + v[j].w * v[j].w); }
            const float r2 = rsqrtf(wave_sum(s2) * (1.f / D) + EPS);
            u32x2* o8 = (u32x2*)(H + (size_t)row * D) + lane;
#pragma unroll
            for (int j = 0; j < 8; ++j) { const f32x4 gg = g2[64 * j]; u32x2 w; w.x = pk2(v[j].x * r2 * gg.x, v[j].y * r2 * gg.y); w.y = pk2(v[j].z * r2 * gg.z, v[j].w * r2 * gg.w); o8[64 * j] = w; }
        }
    }
    SEAM(5);
    if (IN(6)) for (int prep = 0; prep < 1 + ((PROBE_MASK >> 6) & 1); ++prep) { PHASE_IDS; if (prep) xcd_barrier(bar);
        const EpiRelu2 ER{(bf16_t*)(p.ws + WS_Z)};
        for (int u = bx; u < FF / 32; u += G) { f32x16 acc = {};
            wave_gemm32(acc, H, D, MP + 32 * wave, (const bf16_t*)(p.ws + WS_WFF1), D, 32 * u, 32, 0, D, lane);
            wave_epi32(acc, MP + 32 * wave, 32 * u, lane, ER); }
        pg8::Gemm g{H, (const bf16_t*)(p.ws + WS_WFF1), MP, FF, D, D, 0}; pg8::StaticOrder S; S.init(MP, FF, G, bx);
        EpiElem8<EpiRelu2> E{ER};
        pg8::gemm_phase<EpiElem8<EpiRelu2>, pg8::StaticOrder, true, true>(ldsl + RING_OFF, g, S, E);
    }
    SEAM(6);
    if (IN(7)) for (int prep = 0; prep < 1 + ((PROBE_MASK >> 7) & 1); ++prep) { PHASE_IDS; if (prep) xcd_barrier(bar);
        for (int wu = gw; wu < (MS / 32) * (D / 32) * 4; wu += NGW) { const int ks = wu & 3, cb = (wu >> 2) & 63, rb = wu >> 8; f32x16 acc = {};
            wave_gemm32(acc, (const bf16_t*)(p.ws + WS_Z), FF, MP + 32 * rb, (const bf16_t*)(p.ws + WS_WFF2), FF, 32 * cb, 32, 2048 * ks, 2048, lane);
            wave_epi32(acc, 32 * rb, 32 * cb, lane, EpiF32{(float*)(p.ws + WS_SLAB) + (size_t)ks * MS * D, D}); }
        pg8::Gemm g{(const bf16_t*)(p.ws + WS_Z), (const bf16_t*)(p.ws + WS_WFF2), MP, D, FF, FF, 0}; pg8::StaticOrder S; S.init(MP, D, G, bx);
        EpiElem<EpiF32> E{EpiF32{(float*)(p.ws + WS_FO), D}};
        pg8::gemm_phase<EpiElem<EpiF32>, pg8::StaticOrder, true, true>(ldsl + RING_OFF, g, S, E);
    }
    SEAM(7);
    if (IN(8)) for (int prep = 0; prep < 1 + ((PROBE_MASK >> 8) & 1); ++prep) { PHASE_IDS; if (prep) xcd_barrier(bar);
        const float* FO = (const float*)(p.ws + WS_FO);
        for (int row = gw; row < R; row += NGW) {
            const f32x4* fr = (const f32x4*)(FO + (size_t)row * D) + lane; const f32x4* g3 = (const f32x4*)p.g_ffn_post + lane;
            f32x4 v[8]; float s = 0.f;
#pragma unroll
            for (int j = 0; j < 8; ++j) { if (row < MP) v[j] = fr[64 * j]; else { const f32x4* sl = (const f32x4*)((const float*)(p.ws + WS_SLAB) + (size_t)(row - MP) * D) + lane + 64 * j; v[j] = (sl[0] + sl[MS * D / 4]) + (sl[2 * (MS * D / 4)] + sl[3 * (MS * D / 4)]); }
                s += (v[j].x * v[j].x + v[j].y * v[j].y) + (v[j].z * v[j].z + v[j].w * v[j].w); }
            const float r1 = rsqrtf(wave_sum(s) * (1.f / D) + EPS);
            f32x4* orow = (f32x4*)(p.out + O_Y + (size_t)row * D) + lane;
#pragma unroll
            for (int j = 0; j < 8; ++j) orow[64 * j] = orow[64 * j] + v[j] * r1 * g3[64 * j];
        }
    }
#undef IN
#undef SEAM
#undef PHASE_IDS
}

#ifndef MK_SPLIT
#define MK_SPLIT 0
#endif
constexpr int NPHASE = 9;
extern "C" void kernel_launch(void* const* d_in, const int* in_sizes, int n_in, void* d_out, int out_size, void* d_ws, size_t ws_size, hipStream_t stream) {
    static int grid = 0;
    if (grid == 0) {
        if (n_in != 18 || (size_t)out_size != O_END || ws_size < WS_END) { fprintf(stderr, "kernel_launch: unexpected sizes n_in %d out %d ws %zu\n", n_in, out_size, ws_size); grid = -1; return; }
        int dev = 0, cus = 0, per_cu = 0;
        if (hipGetDevice(&dev) != hipSuccess || hipDeviceGetAttribute(&cus, hipDeviceAttributeMultiprocessorCount, dev) != hipSuccess) { grid = -1; return; }
        if (hipFuncSetAttribute((const void*)mega_fwd, hipFuncAttributeMaxDynamicSharedMemorySize, LDS_BYTES) != hipSuccess) { fprintf(stderr, "kernel_launch: hipFuncSetAttribute failed\n"); grid = -1; return; }
        if (hipOccupancyMaxActiveBlocksPerMultiprocessor(&per_cu, (const void*)mega_fwd, NWAVES * 64, LDS_BYTES) != hipSuccess || per_cu < 1) { fprintf(stderr, "kernel_launch: occupancy query says %d blocks per CU\n", per_cu); (void)hipGetLastError(); grid = -1; return; }
        grid = cus;
        if (grid > 256) grid = 256;
        grid &= ~7;
    }
    if (grid <= 0) return;
    (void)hipMemsetAsync((char*)d_ws + WS_CTL, 0, CTL_ZERO_BYTES, stream);
    Params p{};
    p.xp = (const float*)d_in[0]; p.xs = (const float*)d_in[1]; p.ck = (const float*)d_in[2]; p.cv = (const float*)d_in[3]; p.clf = (const float*)d_in[4]; p.sp = (const float*)d_in[5];
    p.g_pre = (const float*)d_in[6]; p.w_in = (const float*)d_in[7]; p.b_f = (const float*)d_in[8]; p.w_up = (const float*)d_in[9]; p.w_pool = (const float*)d_in[10]; p.pscale = (const float*)d_in[11];
    p.w_out = (const float*)d_in[12]; p.g_post = (const float*)d_in[13]; p.g_ffn_pre = (const float*)d_in[14]; p.w_ff1 = (const float*)d_in[15]; p.w_ff2 = (const float*)d_in[16]; p.g_ffn_post = (const float*)d_in[17];
    p.out = (float*)d_out; p.ws = (unsigned char*)d_ws;
#if MK_SPLIT
    for (int k = 0; k < NPHASE; ++k) { p.ph_lo = k; p.ph_hi = k + 1; hipLaunchKernelGGL(mega_fwd, dim3(grid), dim3(NWAVES * 64), LDS_BYTES, stream, p); }
#else
    p.ph_lo = 0; p.ph_hi = NPHASE;
    hipLaunchKernelGGL(mega_fwd, dim3(grid), dim3(NWAVES * 64), LDS_BYTES, stream, p);
#endif
}
```

```cpp
#include <hip/hip_runtime.h>
#include <stdint.h>
#include <stdio.h>

typedef unsigned short bf16_t;
typedef short bf16x8 __attribute__((ext_vector_type(8)));
typedef float f32x4 __attribute__((ext_vector_type(4)));
typedef float f32x2 __attribute__((ext_vector_type(2)));
typedef unsigned u32x4 __attribute__((ext_vector_type(4)));
typedef unsigned u32x2 __attribute__((ext_vector_type(2)));

constexpr int D = 2048, BATCH = 8, SEQ = 2048, MP = BATCH * SEQ;
constexpr int SB_ = 16, SN = 16, MS = SB_ * SN;
constexpr int R = MP + MS;
constexpr int PAST = 2048, NH = 16, DH = 64, AW = 1024, PW = 1024, FF = 8192;
constexpr int NKEY = PAST + SN;
constexpr int NMAIN = 8192;
constexpr int C_Q = 0, C_K = 1024, C_V = 2048, C_U = 3072, C_GA = 4096, C_GB = 6144;
constexpr float EPS = 1e-6f, LOG2E = 1.4426950408889634f, QSCALE = 0.125f * LOG2E;

constexpr size_t O_Y = 0;
constexpr size_t O_KP = (size_t)R * D;
constexpr size_t O_VP = O_KP + (size_t)MP * AW;
constexpr size_t O_LP = O_VP + (size_t)MP * AW;
constexpr size_t O_PP = O_LP + (size_t)MP * NH;
constexpr size_t O_KS = O_PP + (size_t)BATCH * 15 * PW;
constexpr size_t O_VS = O_KS + (size_t)MS * AW;
constexpr size_t O_LS = O_VS + (size_t)MS * AW;
constexpr size_t O_PS = O_LS + (size_t)MS * NH;
constexpr size_t O_END = O_PS + (size_t)SB_ * 15 * PW;

constexpr size_t MiB = 1u << 20;
constexpr size_t WS_WIN = 0, WS_WUP = 33 * MiB, WS_WPOOL = 37 * MiB, WS_WOUT = 38 * MiB, WS_WFF1 = 46 * MiB, WS_WFF2 = 78 * MiB;
constexpr size_t WS_H = 110 * MiB;
constexpr size_t WS_TM = 175 * MiB;
constexpr size_t WS_X = 240 * MiB;
constexpr size_t WS_Q = WS_X, WS_K = WS_Q + (size_t)R * AW * 2, WS_V = WS_K + (size_t)R * AW * 2, WS_U = WS_V + (size_t)R * AW * 2,
                 WS_PO = WS_U + (size_t)R * PW * 2, WS_SA = WS_PO + (size_t)R * PW * 2, WS_SB = WS_SA + (size_t)R * D * 2, WS_XEND = WS_SB + (size_t)R * D * 2;
constexpr size_t WS_Z = WS_X;
constexpr size_t WS_MO = WS_X;
constexpr size_t WS_FO = WS_H;
constexpr size_t WS_LOGF = 533 * MiB;
constexpr size_t WS_CP = 535 * MiB;
constexpr size_t WS_CS = 536 * MiB;
constexpr size_t WS_CTL = 540 * MiB;
constexpr size_t WS_SLAB = 541 * MiB;
constexpr size_t WS_END = 549 * MiB;
static_assert(WS_XEND <= WS_LOGF && WS_Z + (size_t)R * FF * 2 <= WS_LOGF, "ws map");

struct Params {
    const float *xp, *xs, *ck, *cv, *clf, *sp, *g_pre, *w_in, *b_f, *w_up, *w_pool, *pscale, *w_out, *g_post, *g_ffn_pre, *w_ff1, *w_ff2, *g_ffn_post;
    float* out; unsigned char* ws; int ph_lo, ph_hi;
};

__device__ __forceinline__ unsigned f2bf(float f) { unsigned u = __builtin_bit_cast(unsigned, f); return (u + 0x7fffu + ((u >> 16) & 1u)) >> 16; }
__device__ __forceinline__ unsigned pk2(float lo, float hi) { return f2bf(lo) | (f2bf(hi) << 16); }
__device__ __forceinline__ float bf2f(unsigned short b) { return __builtin_bit_cast(float, (unsigned)b << 16); }
__device__ __forceinline__ float bflo(unsigned w) { return __builtin_bit_cast(float, w << 16); }
__device__ __forceinline__ float bfhi(unsigned w) { return __builtin_bit_cast(float, w & 0xffff0000u); }
__device__ __forceinline__ float wave_sum(float v) {
#pragma unroll
    for (int o = 1; o < 64; o <<= 1) v += __shfl_xor(v, o);
    return v;
}
__device__ __forceinline__ int tid_opaque() { int t = threadIdx.x; asm volatile("" : "+v"(t)); return t; }
__device__ __forceinline__ float sigmoidf_(float x) { return __builtin_amdgcn_rcpf(1.0f + __builtin_amdgcn_exp2f(-LOG2E * x)); }
__device__ __forceinline__ const float* xrow(const Params& p, int row) { return row < MP ? p.xp + (size_t)row * D : p.xs + (size_t)(row - MP) * D; }

struct TrRegs { f32x4 v[8]; };
__device__ __forceinline__ void tr_load(TrRegs& t, const float* src, int ld, int col0, int k0, int nvalid, int lane) {
    const int n4 = (lane & 7) * 4;
#pragma unroll
    for (int i = 0; i < 8; ++i) { const int kk = 8 * i + (lane >> 3); t.v[i] = (n4 < nvalid) ? *(const f32x4*)(src + (size_t)(k0 + kk) * ld + col0 + n4) : (f32x4){0.f, 0.f, 0.f, 0.f}; }
}
__device__ __forceinline__ void tr_store(const TrRegs& t, bf16_t* dst, int pitch, int row0, int k0, int nvalid, float* scr, int lane) {
    const int n4 = (lane & 7) * 4;
#pragma unroll
    for (int i = 0; i < 8; ++i) { const int kk = 8 * i + (lane >> 3); float* q = scr + kk * 33 + n4; q[0] = t.v[i].x; q[1] = t.v[i].y; q[2] = t.v[i].z; q[3] = t.v[i].w; }
    __builtin_amdgcn_s_waitcnt(0xc07f); __builtin_amdgcn_wave_barrier();
    const int c = lane & 7;
#pragma unroll
    for (int j = 0; j < 4; ++j) { const int n = (lane >> 3) + 8 * j; const float* s = scr + (8 * c) * 33 + n;
        u32x4 o; o.x = pk2(s[0 * 33], s[1 * 33]); o.y = pk2(s[2 * 33], s[3 * 33]); o.z = pk2(s[4 * 33], s[5 * 33]); o.w = pk2(s[6 * 33], s[7 * 33]);
        if (n < nvalid) *(u32x4*)(dst + (size_t)(row0 + n) * pitch + k0 + 8 * c) = o; }
    __builtin_amdgcn_s_waitcnt(0xc07f); __builtin_amdgcn_wave_barrier();
}
struct TrItem { const float* src; bf16_t* dst; int ld, col0, k0, pitch, row0, nvalid; };
__device__ __forceinline__ TrItem tr_decode(const Params& p, int it) {
    bf16_t* Win = (bf16_t*)(p.ws + WS_WIN); bf16_t* Wup = (bf16_t*)(p.ws + WS_WUP); bf16_t* Wpool = (bf16_t*)(p.ws + WS_WPOOL);
    bf16_t* Wout = (bf16_t*)(p.ws + WS_WOUT); bf16_t* Wff1 = (bf16_t*)(p.ws + WS_WFF1); bf16_t* Wff2 = (bf16_t*)(p.ws + WS_WFF2);
    constexpr int NB_IN = 257;
    constexpr int I_IN = (D / 64) * NB_IN, I_UP = (AW / 64) * (D / 32), I_POOL = 4 * (256 / 64) * (512 / 32), I_OUT = (D / 64) * (D / 32), I_FF1 = (D / 64) * (FF / 32);
    int r = it;
    if (r < I_IN) { const int kb = r / NB_IN, nb = r % NB_IN, r0 = nb * 32;
        const int c0 = r0 < 3072 ? r0 : (r0 < NMAIN ? r0 + 16 : 3072 + (r0 - NMAIN));
        return TrItem{p.w_in, Win, 8208, c0, kb * 64, D, r0, r0 < NMAIN ? 32 : 16}; }
    r -= I_IN;
    if (r < I_UP) { const int nblk = D / 32; return TrItem{p.w_up, Wup, D, (r % nblk) * 32, (r / nblk) * 64, AW, (r % nblk) * 32, 32}; }
    r -= I_UP;
    if (r < I_POOL) { const int g = r / 64, q = r % 64, kb = q / 16, nb = q % 16; return TrItem{p.w_pool + (size_t)g * 256 * 512, Wpool, 512, nb * 32, kb * 64, 256, g * 512 + nb * 32, 32}; }
    r -= I_POOL;
    if (r < I_OUT) { const int nblk = D / 32; return TrItem{p.w_out, Wout, D, (r % nblk) * 32, (r / nblk) * 64, D, (r % nblk) * 32, 32}; }
    r -= I_OUT;
    if (r < I_FF1) { const int nblk = FF / 32; return TrItem{p.w_ff1, Wff1, FF, (r % nblk) * 32, (r / nblk) * 64, D, (r % nblk) * 32, 32}; }
    r -= I_FF1;
    { const int nblk = D / 32; return TrItem{p.w_ff2, Wff2, D, (r % nblk) * 32, (r / nblk) * 64, FF, (r % nblk) * 32, 32}; }
}
__device__ __forceinline__ void convert_weights(const Params& p, float* scr, int gw, int NGW, int lane) {
    constexpr int NITEMS = (D / 64) * 257 + (AW / 64) * (D / 32) + 4 * (256 / 64) * (512 / 32) + (D / 64) * (D / 32) + (D / 64) * (FF / 32) + (FF / 64) * (D / 32);
    if (gw >= NITEMS) return;
    TrItem cur = tr_decode(p, gw); TrRegs ra, rb;
    tr_load(ra, cur.src, cur.ld, cur.col0, cur.k0, cur.nvalid, lane);
    for (int it = gw; it < NITEMS; it += 2 * NGW) {
        const bool h1 = it + NGW < NITEMS; TrItem n1 = cur; if (h1) { n1 = tr_decode(p, it + NGW); tr_load(rb, n1.src, n1.ld, n1.col0, n1.k0, n1.nvalid, lane); }
        tr_store(ra, cur.dst, cur.pitch, cur.row0, cur.k0, cur.nvalid, scr, lane);
        const bool h2 = it + 2 * NGW < NITEMS; if (h2) { cur = tr_decode(p, it + 2 * NGW); tr_load(ra, cur.src, cur.ld, cur.col0, cur.k0, cur.nvalid, lane); }
        if (h1) tr_store(rb, n1.dst, n1.pitch, n1.row0, n1.k0, n1.nvalid, scr, lane);
    }
}

__device__ __forceinline__ void rms_row_to_bf16(const float* xr_, const float* g, bf16_t* orow, int lane) {
    const f32x4* xr = (const f32x4*)xr_ + lane; const f32x4* gr = (const f32x4*)g + lane;
    f32x4 v[8]; float s = 0.f;
#pragma unroll
    for (int j = 0; j < 8; ++j) { v[j] = xr[64 * j]; s += (v[j].x * v[j].x + v[j].y * v[j].y) + (v[j].z * v[j].z + v[j].w * v[j].w); }
    const float rstd = rsqrtf(wave_sum(s) * (1.f / D) + EPS);
    u32x2* o8 = (u32x2*)orow + lane;
#pragma unroll
    for (int j = 0; j < 8; ++j) { const f32x4 gg = gr[64 * j]; u32x2 w; w.x = pk2(v[j].x * rstd * gg.x, v[j].y * rstd * gg.y); w.y = pk2(v[j].z * rstd * gg.z, v[j].w * rstd * gg.w); o8[64 * j] = w; }
}
__device__ __forceinline__ void rms_row2_to_bf16(const float* xa_, const float* xb_, const float* g, bf16_t* oa, bf16_t* ob, int lane) {
    const f32x4* xa = (const f32x4*)xa_ + lane; const f32x4* xb = (const f32x4*)xb_ + lane; const f32x4* gr = (const f32x4*)g + lane;
    f32x4 va[8], vb[8]; float sa = 0.f, sb = 0.f;
#pragma unroll
    for (int j = 0; j < 8; ++j) { va[j] = xa[64 * j]; vb[j] = xb[64 * j]; }
#pragma unroll
    for (int j = 0; j < 8; ++j) { sa += (va[j].x * va[j].x + va[j].y * va[j].y) + (va[j].z * va[j].z + va[j].w * va[j].w); sb += (vb[j].x * vb[j].x + vb[j].y * vb[j].y) + (vb[j].z * vb[j].z + vb[j].w * vb[j].w); }
#pragma unroll
    for (int o = 1; o < 64; o <<= 1) { sa += __shfl_xor(sa, o); sb += __shfl_xor(sb, o); }
    const float ra = rsqrtf(sa * (1.f / D) + EPS), rb = rsqrtf(sb * (1.f / D) + EPS);
    u32x2* pa = (u32x2*)oa + lane; u32x2* pb = (u32x2*)ob + lane;
#pragma unroll
    for (int j = 0; j < 8; ++j) { const f32x4 gg = gr[64 * j]; u32x2 w; w.x = pk2(va[j].x * ra * gg.x, va[j].y * ra * gg.y); w.y = pk2(va[j].z * ra * gg.z, va[j].w * ra * gg.w); pa[64 * j] = w;
        u32x2 w2; w2.x = pk2(vb[j].x * rb * gg.x, vb[j].y * rb * gg.y); w2.y = pk2(vb[j].z * rb * gg.z, vb[j].w * rb * gg.w); pb[64 * j] = w2; }
}
template <int WM, int WN, int TM, int TN, class Epi>
__device__ __forceinline__ void sgemm_tile(unsigned char* smem, const bf16_t* __restrict__ A, int lda, const bf16_t* __restrict__ Bt, int ldb, int K, int row0, int col0, const Epi& E) {
    static_assert(WM * WN == 8, "8 waves");
    constexpr int BM = WM * TM * 16, BN = WN * TN * 16, CA = BM * 8, CB = BN * 8, NA = (CA + 511) / 512, NB = (CB + 511) / 512;
    const int tid = threadIdx.x, lane = tid & 63, wid = tid >> 6, wr = wid / WN, wc = wid % WN, fr = lane & 15, fq = lane >> 4;
    unsigned char* sA = smem; unsigned char* sB = smem + BM * 128;
    f32x4 acc[TM][TN];
#pragma unroll
    for (int m = 0; m < TM; ++m)
#pragma unroll
        for (int n = 0; n < TN; ++n) acc[m][n] = (f32x4){0.f, 0.f, 0.f, 0.f};
    u32x4 ra[NA], rb[NB];
    const int nk = K / 64;
#define SG_GLOAD(kt) do { \
    _Pragma("unroll") for (int i = 0; i < NA; ++i) { const int c = tid + i * 512; if (c < CA) ra[i] = *(const u32x4*)(A + (size_t)(row0 + (c >> 3)) * lda + (kt) * 64 + (c & 7) * 8); } \
    _Pragma("unroll") for (int i = 0; i < NB; ++i) { const int c = tid + i * 512; if (c < CB) rb[i] = *(const u32x4*)(Bt + (size_t)(col0 + (c >> 3)) * ldb + (kt) * 64 + (c & 7) * 8); } } while (0)
    SG_GLOAD(0);
    for (int kt = 0; kt < nk; ++kt) {
        __syncthreads();
#pragma unroll
        for (int i = 0; i < NA; ++i) { const int c = tid + i * 512; if (c < CA) { const int r = c >> 3, ch = c & 7; *(u32x4*)(sA + r * 128 + ((ch ^ (r & 7)) << 4)) = ra[i]; } }
#pragma unroll
        for (int i = 0; i < NB; ++i) { const int c = tid + i * 512; if (c < CB) { const int r = c >> 3, ch = c & 7; *(u32x4*)(sB + r * 128 + ((ch ^ (r & 7)) << 4)) = rb[i]; } }
        __syncthreads();
        if (kt + 1 < nk) SG_GLOAD(kt + 1);
#pragma unroll
        for (int kk = 0; kk < 2; ++kk) {
            bf16x8 af[TM], bfr[TN];
#pragma unroll
            for (int m = 0; m < TM; ++m) { const int r = (wr * TM + m) * 16 + fr, ch = kk * 4 + fq; af[m] = *(const bf16x8*)(sA + r * 128 + ((ch ^ (r & 7)) << 4)); }
#pragma unroll
            for (int n = 0; n < TN; ++n) { const int r = (wc * TN + n) * 16 + fr, ch = kk * 4 + fq; bfr[n] = *(const bf16x8*)(sB + r * 128 + ((ch ^ (r & 7)) << 4)); }
#pragma unroll
            for (int m = 0; m < TM; ++m)
#pragma unroll
                for (int n = 0; n < TN; ++n) acc[m][n] = __builtin_amdgcn_mfma_f32_16x16x32_bf16(bfr[n], af[m], acc[m][n], 0, 0, 0);
        }
    }
#undef SG_GLOAD
#pragma unroll
    for (int m = 0; m < TM; ++m)
#pragma unroll
        for (int n = 0; n < TN; ++n) E(row0 + (wr * TM + m) * 16 + fr, col0 + (wc * TN + n) * 16 + 4 * fq, acc[m][n]);
}

__device__ __forceinline__ void st_bf16x4(bf16_t* p, f32x4 v) { u32x2 w; w.x = pk2(v.x, v.y); w.y = pk2(v.z, v.w); *(u32x2*)p = w; }
__device__ __forceinline__ void st_bf16x8(bf16_t* p, f32x4 a, f32x4 b) { u32x4 w; w.x = pk2(a.x, a.y); w.y = pk2(a.z, a.w); w.z = pk2(b.x, b.y); w.w = pk2(b.z, b.w); *(u32x4*)p = w; }
__device__ __forceinline__ void ld_bf16x8(const bf16_t* p, f32x4& a, f32x4& b) { const u32x4 w = *(const u32x4*)p; a = (f32x4){bflo(w.x), bfhi(w.x), bflo(w.y), bfhi(w.y)}; b = (f32x4){bflo(w.z), bfhi(w.z), bflo(w.w), bfhi(w.w)}; }
__device__ __forceinline__ f32x4 sig4(f32x4 v) { return (f32x4){sigmoidf_(v.x), sigmoidf_(v.y), sigmoidf_(v.z), sigmoidf_(v.w)}; }
__device__ __forceinline__ f32x4 ld_bf16x4(const bf16_t* p) { const u32x2 w = *(const u32x2*)p; return (f32x4){bflo(w.x), bfhi(w.x), bflo(w.y), bfhi(w.y)}; }

struct EpiIn {
    bf16_t *Q, *Kb, *Vb, *U, *SA, *SB; float* out; const float* pscale;
    __device__ __forceinline__ void operator()(int row, int col, f32x4 v) const {
        if (col < C_K) { st_bf16x4(Q + (size_t)row * AW + col, v * QSCALE); }
        else if (col < C_U) {
            const bool isk = col < C_V; const int c = col - (isk ? C_K : C_V);
            st_bf16x4((isk ? Kb : Vb) + (size_t)row * AW + c, v);
            float* o = row < MP ? out + (isk ? O_KP : O_VP) + (size_t)row * AW + c : out + (isk ? O_KS : O_VS) + (size_t)(row - MP) * AW + c;
            *(f32x4*)o = v;
        } else if (col < C_GA) {
            const int c = col - C_U; st_bf16x4(U + (size_t)row * PW + c, v);
            if (row < MP) { const int b = row / SEQ, t = row % SEQ; if (t >= SEQ - 15) *(f32x4*)(out + O_PP + ((size_t)b * 15 + (t - (SEQ - 15))) * PW + c) = v; }
            else { const int rs = row - MP, b = rs / SN, i = rs % SN; if (i >= 1) *(f32x4*)(out + O_PS + ((size_t)b * 15 + (i - 1)) * PW + c) = v; }
        } else if (col < C_GB) { const int c = col - C_GA; f32x4 s = {sigmoidf_(v.x), sigmoidf_(v.y), sigmoidf_(v.z), sigmoidf_(v.w)}; st_bf16x4(SA + (size_t)row * D + c, s); }
        else { const int c = col - C_GB; const f32x4 ps = *(const f32x4*)(pscale + c); f32x4 s = {sigmoidf_(v.x) * ps.x, sigmoidf_(v.y) * ps.y, sigmoidf_(v.z) * ps.z, sigmoidf_(v.w) * ps.w}; st_bf16x4(SB + (size_t)row * D + c, s); }
    }
    __device__ __forceinline__ void op8(int row, int col, f32x4 a, f32x4 b) const {
        if (col < C_K) { st_bf16x8(Q + (size_t)row * AW + col, a * QSCALE, b * QSCALE); }
        else if (col < C_U) { const bool isk = col < C_V; const int c = col - (isk ? C_K : C_V);
            st_bf16x8((isk ? Kb : Vb) + (size_t)row * AW + c, a, b);
            float* o = out + (isk ? O_KP : O_VP) + (size_t)row * AW + c; *(f32x4*)o = a; *(f32x4*)(o + 4) = b;
        } else if (col < C_GA) { const int c = col - C_U; st_bf16x8(U + (size_t)row * PW + c, a, b);
            const int bb = row / SEQ, t = row % SEQ; if (t >= SEQ - 15) { float* o = out + O_PP + ((size_t)bb * 15 + (t - (SEQ - 15))) * PW + c; *(f32x4*)o = a; *(f32x4*)(o + 4) = b; }
        } else if (col < C_GB) { st_bf16x8(SA + (size_t)row * D + (col - C_GA), sig4(a), sig4(b)); }
        else { const int c = col - C_GB; const f32x4 p0 = *(const f32x4*)(pscale + c), p1 = *(const f32x4*)(pscale + c + 4); st_bf16x8(SB + (size_t)row * D + c, sig4(a) * p0, sig4(b) * p1); }
    }
};
struct EpiLogf {
    float* LOGF; float* out; const float* b_f;
    __device__ __forceinline__ void operator()(int row, int col, f32x4 v) const {
        const f32x4 b = *(const f32x4*)(b_f + col); f32x4 r;
#pragma unroll
        for (int e = 0; e < 4; ++e) { const float z = v[e] + b[e]; r[e] = fminf(z, 0.f) - log1pf(__expf(-fabsf(z))); }
        *(f32x4*)(LOGF + (size_t)row * NH + col) = r;
        float* o = row < MP ? out + O_LP + (size_t)row * NH + col : out + O_LS + (size_t)(row - MP) * NH + col;
        *(f32x4*)o = r;
    }
};
__device__ __forceinline__ float wave_incl_scan(float v, int lane) {
#pragma unroll
    for (int o = 1; o < 64; o <<= 1) { const float t = __shfl_up(v, o); if (lane >= o) v += t; }
    return v;
}
__device__ __forceinline__ void pool_chunk(const Params& p, int row, int ch) {
    const bf16_t* U = (const bf16_t*)(p.ws + WS_U); bf16_t* PO = (bf16_t*)(p.ws + WS_PO);
    const int c0 = ch * 8, g = c0 >> 8, w = 2 << g;
    float s[8]; float cur[8];
#pragma unroll
    for (int e = 0; e < 8; ++e) s[e] = 0.f;
    float cnt;
    if (row < MP) { const int t = row % SEQ; const int n = (t + 1 < w) ? t + 1 : w; cnt = (float)n;
        for (int j = 0; j < n; ++j) { const u32x4 v = *(const u32x4*)(U + (size_t)(row - j) * PW + c0);
            const float f[8] = {bflo(v.x), bfhi(v.x), bflo(v.y), bfhi(v.y), bflo(v.z), bfhi(v.z), bflo(v.w), bfhi(v.w)};
#pragma unroll
            for (int e = 0; e < 8; ++e) { s[e] += f[e]; if (j == 0) cur[e] = f[e]; } }
    } else { const int rs = row - MP, b = rs / SN, i = rs % SN; cnt = (float)w;
        for (int j = 0; j < w; ++j) { const int e_ = 15 + i - j;
            float f[8];
            if (e_ >= 15) { const u32x4 v = *(const u32x4*)(U + (size_t)(MP + b * SN + (e_ - 15)) * PW + c0);
                f[0] = bflo(v.x); f[1] = bfhi(v.x); f[2] = bflo(v.y); f[3] = bfhi(v.y); f[4] = bflo(v.z); f[5] = bfhi(v.z); f[6] = bflo(v.w); f[7] = bfhi(v.w); }
            else { const f32x4 a = *(const f32x4*)(p.sp + ((size_t)b * 15 + e_) * PW + c0), c = *(const f32x4*)(p.sp + ((size_t)b * 15 + e_) * PW + c0 + 4);
                f[0] = a.x; f[1] = a.y; f[2] = a.z; f[3] = a.w; f[4] = c.x; f[5] = c.y; f[6] = c.z; f[7] = c.w; }
#pragma unroll
            for (int e = 0; e < 8; ++e) { s[e] += f[e]; if (j == 0) cur[e] = f[e]; } }
    }
    u32x4 o; o.x = pk2(s[0] / cnt - cur[0], s[1] / cnt - cur[1]); o.y = pk2(s[2] / cnt - cur[2], s[3] / cnt - cur[3]); o.z = pk2(s[4] / cnt - cur[4], s[5] / cnt - cur[5]); o.w = pk2(s[6] / cnt - cur[6], s[7] / cnt - cur[7]);
    *(u32x4*)(PO + (size_t)row * PW + c0) = o;
}
struct EpiPool { const bf16_t* SB; bf16_t* T;
    __device__ __forceinline__ void operator()(int row, int col, f32x4 v) const { const f32x4 s = ld_bf16x4(SB + (size_t)row * D + col); st_bf16x4(T + (size_t)row * D + col, v * s); }
    struct Regs { u32x4 s; };
    __device__ __forceinline__ void load(Regs& r, int row, int col) const { r.s = *(const u32x4*)(SB + (size_t)row * D + col); }
    __device__ __forceinline__ void apply(const Regs& r, int row, int col, f32x4 a, f32x4 b) const {
        const f32x4 s0 = {bflo(r.s.x), bfhi(r.s.x), bflo(r.s.y), bfhi(r.s.y)}, s1 = {bflo(r.s.z), bfhi(r.s.z), bflo(r.s.w), bfhi(r.s.w)}; st_bf16x8(T + (size_t)row * D + col, a * s0, b * s1); } };
struct EpiUp { const bf16_t* SA; bf16_t* T; bf16_t* O;
    __device__ __forceinline__ void operator()(int row, int col, f32x4 v) const { const f32x4 s = ld_bf16x4(SA + (size_t)row * D + col), t = ld_bf16x4(T + (size_t)row * D + col); st_bf16x4(O + (size_t)row * D + col, v * s + t); }
    struct Regs { u32x4 s, t; };
    __device__ __forceinline__ void load(Regs& r, int row, int col) const { r.s = *(const u32x4*)(SA + (size_t)row * D + col); r.t = *(const u32x4*)(T + (size_t)row * D + col); }
    __device__ __forceinline__ void apply(const Regs& r, int row, int col, f32x4 a, f32x4 b) const {
        const f32x4 s0 = {bflo(r.s.x), bfhi(r.s.x), bflo(r.s.y), bfhi(r.s.y)}, s1 = {bflo(r.s.z), bfhi(r.s.z), bflo(r.s.w), bfhi(r.s.w)};
        const f32x4 t0 = {bflo(r.t.x), bfhi(r.t.x), bflo(r.t.y), bfhi(r.t.y)}, t1 = {bflo(r.t.z), bfhi(r.t.z), bflo(r.t.w), bfhi(r.t.w)}; st_bf16x8(O + (size_t)row * D + col, a * s0 + t0, b * s1 + t1); } };
struct EpiF32 { float* C; int ldc;
    __device__ __forceinline__ void operator()(int row, int col, f32x4 v) const { *(f32x4*)(C + (size_t)row * ldc + col) = v; } };
struct EpiBf16 { bf16_t* C; int ldc;
    __device__ __forceinline__ void op8(int row, int col, f32x4 a, f32x4 b) const { st_bf16x8(C + (size_t)row * ldc + col, a, b); } };
struct EpiRelu2 { bf16_t* Z;
    __device__ __forceinline__ void operator()(int row, int col, f32x4 v) const { f32x4 r;
#pragma unroll
        for (int e = 0; e < 4; ++e) { const float a = fmaxf(v[e], 0.f); r[e] = a * a; }
        st_bf16x4(Z + (size_t)row * FF + col, r); }
    __device__ __forceinline__ void op8(int row, int col, f32x4 a, f32x4 b) const { const f32x4 z = {0.f, 0.f, 0.f, 0.f}; a = __builtin_elementwise_max(a, z); b = __builtin_elementwise_max(b, z); st_bf16x8(Z + (size_t)row * FF + col, a * a, b * b); } };

namespace pg8 {
#define PG8_LAS __attribute__((address_space(3)))


constexpr int BM = 256, BK = 64, HALF = 128, HTB = HALF * BK * 2  , STAGE_BYTES = 8 * HTB, NXCD = 8, WGM = 8;

__host__ __device__ __forceinline__ int lds_byte(int r, int c) { const int st = (r >> 4) * 2 + (c >> 5), rr = r & 15, cc = c & 31, ob = rr * 64 + cc * 2; return st * 1024 + (ob ^ (((ob >> 9) & 1) << 5)); }
__host__ __device__ __forceinline__ void stage_rc(int b, int& R, int& C) { const int st = b / 1024, sb = b % 1024, swz = sb ^ (((sb >> 9) & 1) << 5); R = (st >> 1) * 16 + swz / 64; C = (st & 1) * 32 + (swz % 64) / 2; }
__host__ __device__ __forceinline__ int perm32(int rho) { const int n = rho >> 4, i = rho & 15; return 8 * (i >> 2) + 4 * n + (i & 3); }

struct Unit { int pm, pn; };
struct Gemm { const bf16_t* A; const bf16_t* Bt; int M, N, K, lda, agrp; };

struct StaticOrder {
    int nM, nN, nwg, G, c, rot = 0;
    __host__ __device__ void init(int M, int N, int G_, int c_) { nM = M / BM; nN = N / BM; nwg = nM * nN; G = G_; c = c_; }
    __host__ __device__ bool next(int i, Unit& u) const {
        const long L = (long)i * G + c; if (L >= nwg) return false;
        int wgid = (int)L; { const int q = nwg / NXCD, r = nwg % NXCD, xcd = wgid % NXCD, off = wgid / NXCD; wgid = (xcd < r ? xcd * (q + 1) : r * (q + 1) + (xcd - r) * q) + off; }
        const int nig = WGM * nN, gid = wgid / nig, fm = gid * WGM, gsz = (nM - fm) < WGM ? (nM - fm) : WGM;
        u.pm = fm + ((wgid % nig) % gsz); u.pn = ((wgid % nig) / gsz + rot) % nN; return true;
    }
    __device__ __forceinline__ void a_ready(const Unit&) const {}
    __device__ __forceinline__ void done(const Unit&) const {}
};

template <class Epi, class Sched, bool ALIGN_EPI = false, bool SP2 = false>
__device__ __forceinline__ void gemm_phase(PG8_LAS unsigned char* lds, const Gemm g, const Sched& S, const Epi& E) {
    const int tid = tid_opaque(), wid = __builtin_amdgcn_readfirstlane(tid >> 6), lane = tid & 63, wr = wid >> 2, wc = wid & 3, fr = lane & 15, fq = lane >> 4;
    const int K = g.K, nt = K / BK;
    unsigned voffA[2], voffB[2];
#pragma unroll
    for (int i = 0; i < 2; ++i) { int R, C; stage_rc(tid * 16 + i * 8192, R, C); const int Rb = Epi::PERM ? ((R & ~31) + perm32(R & 31)) : R;
        voffA[i] = (unsigned)(R * g.lda + C) * 2u; voffB[i] = (unsigned)(Rb * K + C) * 2u; }
    const size_t kstep = (size_t)(BK * 2);
    const size_t hstepA = (size_t)HALF * g.lda * 2, hstepB = (size_t)HALF * K * 2;
    const size_t tstepA = 2 * hstepA, tstepB = 2 * hstepB;
    const unsigned ldsw = (unsigned)wid * 1024u;
    const int aoff = lds_byte(wr * 64 + fr, fq * 8), boff = lds_byte(wc * 32 + fr, fq * 8);
#define PG8_SA(b, h) (((b) * 2 + (h)) * HTB)
#define PG8_SB(b, h) ((4 + (b) * 2 + (h)) * HTB)
#define PG8_STAGE(bufoff, gbase, voff) do { _Pragma("unroll") for (int _i = 0; _i < 2; ++_i) \
        __builtin_amdgcn_global_load_lds((const unsigned*)((const char*)(gbase) + (voff)[_i]), (PG8_LAS unsigned*)(lds + (bufoff) + ldsw + _i * 8192), 16, 0, 0); } while (0)
#define PG8_LDA(dst, b, h) do { _Pragma("unroll") for (int m = 0; m < 4; ++m) _Pragma("unroll") for (int k = 0; k < 2; ++k) dst[m][k] = *(const PG8_LAS bf16x8*)(lds + PG8_SA(b, h) + aoff + m * 2048 + k * 1024); } while (0)
#define PG8_LDB(dst, b, h) do { _Pragma("unroll") for (int n = 0; n < 2; ++n) _Pragma("unroll") for (int k = 0; k < 2; ++k) dst[n][k] = *(const PG8_LAS bf16x8*)(lds + PG8_SB(b, h) + boff + n * 2048 + k * 1024); } while (0)
#define PG8_MMA(ai, bj, At, Bt) do { __builtin_amdgcn_s_setprio(1); _Pragma("unroll") for (int m = 0; m < 4; ++m) _Pragma("unroll") for (int n = 0; n < 2; ++n) _Pragma("unroll") for (int k = 0; k < 2; ++k) \
        acc[ai][bj][m][n] = __builtin_amdgcn_mfma_f32_16x16x32_bf16(Bt[n][k], At[m][k], acc[ai][bj][m][n], 0, 0, 0); __builtin_amdgcn_s_setprio(0); } while (0)
#define PG8_WAIT_V(n) asm volatile("s_waitcnt vmcnt(" #n ")" ::: "memory")
#define PG8_WAIT_L(n) asm volatile("s_waitcnt lgkmcnt(" #n ")" ::: "memory")
#define PG8_BAR __builtin_amdgcn_s_barrier()
#define PG8_SCHED __builtin_amdgcn_sched_barrier(0)
    Unit cur, nxt; int ui = 0;
    if (!S.next(0, cur)) return;
    f32x4 acc[2][2][4][2];
#pragma unroll
    for (int a = 0; a < 2; ++a)
#pragma unroll
        for (int b = 0; b < 2; ++b)
#pragma unroll
            for (int m = 0; m < 4; ++m)
#pragma unroll
                for (int n = 0; n < 2; ++n) acc[a][b][m][n] = (f32x4){0.f, 0.f, 0.f, 0.f};
    bf16x8 At[4][2], B0[2][2], B1[2][2];
    const char* cA = (const char*)g.A + (size_t)cur.pm * tstepA + (size_t)((cur.pn >> 1) * g.agrp) * 2; const char* cB = (const char*)g.Bt + (size_t)cur.pn * tstepB;
    S.a_ready(cur);
    if constexpr (SP2) {
        PG8_STAGE(PG8_SB(0, 0), cB, voffB); PG8_STAGE(PG8_SB(0, 1), cB + hstepB, voffB); PG8_STAGE(PG8_SA(0, 0), cA, voffA); PG8_STAGE(PG8_SA(0, 1), cA + hstepA, voffA);
        if (wr == 1) PG8_BAR;
        PG8_WAIT_V(2); PG8_BAR;
        PG8_STAGE(PG8_SB(1, 0), cB + kstep, voffB); PG8_STAGE(PG8_SA(1, 0), cA + kstep, voffA); PG8_STAGE(PG8_SB(1, 1), cB + hstepB + kstep, voffB);
        PG8_WAIT_V(6); PG8_BAR;
    } else {
        PG8_STAGE(PG8_SB(0, 0), cB, voffB); PG8_STAGE(PG8_SA(0, 0), cA, voffA); PG8_STAGE(PG8_SB(0, 1), cB + hstepB, voffB); PG8_STAGE(PG8_SA(0, 1), cA + hstepA, voffA);
        if (wr == 1) PG8_BAR;
        PG8_WAIT_V(4); PG8_BAR;
        PG8_STAGE(PG8_SB(1, 0), cB + kstep, voffB); PG8_STAGE(PG8_SA(1, 0), cA + kstep, voffA); PG8_STAGE(PG8_SB(1, 1), cB + hstepB + kstep, voffB);
        PG8_WAIT_V(6); PG8_BAR;
    }
    for (;;) {
        const bool has_next = S.next(ui + 1, nxt);
        const char* nA = has_next ? (const char*)g.A + (size_t)nxt.pm * tstepA + (size_t)((nxt.pn >> 1) * g.agrp) * 2 : cA; const char* nB = has_next ? (const char*)g.Bt + (size_t)nxt.pn * tstepB : cB;
        for (int t = 0; t < nt; t += 2) {
            const bool last = (t == nt - 2);
            const char* a1 = cA + (size_t)(t + 1) * kstep;
            const char* a2 = last ? nA : cA + (size_t)(t + 2) * kstep; const char* b2 = last ? nB : cB + (size_t)(t + 2) * kstep;
            const char* a3 = a2 + kstep; const char* b3 = b2 + kstep;
            if (last && has_next) S.a_ready(nxt);
            if constexpr (SP2) {
            PG8_LDB(B0, 0, 0); PG8_LDB(B1, 0, 1); PG8_SCHED; PG8_LDA(At, 0, 0); PG8_STAGE(PG8_SA(1, 1), a1 + hstepA, voffA);
            PG8_WAIT_V(8); PG8_WAIT_L(0); PG8_BAR; PG8_MMA(0, 0, At, B0); PG8_MMA(0, 1, At, B1); PG8_BAR; PG8_SCHED;
            PG8_LDA(At, 0, 1); PG8_STAGE(PG8_SB(0, 0), b2, voffB); PG8_STAGE(PG8_SB(0, 1), b2 + hstepB, voffB); PG8_STAGE(PG8_SA(0, 0), a2, voffA);
            PG8_WAIT_V(8); PG8_WAIT_L(0); PG8_BAR; PG8_MMA(1, 0, At, B0); PG8_MMA(1, 1, At, B1); PG8_BAR; PG8_SCHED;
            PG8_LDB(B0, 1, 0); PG8_LDB(B1, 1, 1); PG8_SCHED; PG8_LDA(At, 1, 0); PG8_STAGE(PG8_SA(0, 1), a2 + hstepA, voffA);
            PG8_WAIT_V(8); PG8_WAIT_L(0); PG8_BAR; PG8_MMA(0, 0, At, B0); PG8_MMA(0, 1, At, B1); PG8_BAR; PG8_SCHED;
            PG8_LDA(At, 1, 1); PG8_STAGE(PG8_SB(1, 0), b3, voffB); PG8_STAGE(PG8_SB(1, 1), b3 + hstepB, voffB); PG8_STAGE(PG8_SA(1, 0), a3, voffA);
            PG8_WAIT_V(8); PG8_WAIT_L(0); PG8_BAR; PG8_MMA(1, 0, At, B0); PG8_MMA(1, 1, At, B1); PG8_BAR; PG8_SCHED;
            } else {
            PG8_LDB(B0, 0, 0); PG8_SCHED; PG8_LDA(At, 0, 0); PG8_STAGE(PG8_SA(1, 1), a1 + hstepA, voffA);
            PG8_WAIT_L(8); PG8_BAR; PG8_WAIT_L(0); PG8_MMA(0, 0, At, B0); PG8_BAR; PG8_SCHED;
            PG8_LDB(B1, 0, 1); PG8_STAGE(PG8_SB(0, 0), b2, voffB);
            PG8_BAR; PG8_WAIT_L(0); PG8_MMA(0, 1, At, B1); PG8_BAR;
            PG8_LDA(At, 0, 1); PG8_STAGE(PG8_SA(0, 0), a2, voffA);
            PG8_BAR; PG8_WAIT_L(0); PG8_MMA(1, 0, At, B0); PG8_BAR; PG8_SCHED;
            PG8_STAGE(PG8_SB(0, 1), b2 + hstepB, voffB);
            PG8_WAIT_V(6); PG8_BAR; PG8_MMA(1, 1, At, B1); PG8_BAR;
            PG8_LDB(B0, 1, 0); PG8_SCHED; PG8_LDA(At, 1, 0); PG8_STAGE(PG8_SA(0, 1), a2 + hstepA, voffA);
            PG8_WAIT_L(8); PG8_BAR; PG8_WAIT_L(0); PG8_MMA(0, 0, At, B0); PG8_BAR; PG8_SCHED;
            PG8_LDB(B1, 1, 1); PG8_STAGE(PG8_SB(1, 0), b3, voffB);
            PG8_BAR; PG8_WAIT_L(0); PG8_MMA(0, 1, At, B1); PG8_BAR;
            PG8_LDA(At, 1, 1); PG8_STAGE(PG8_SA(1, 0), a3, voffA);
            PG8_BAR; PG8_WAIT_L(0); PG8_MMA(1, 0, At, B0); PG8_BAR; PG8_SCHED;
            PG8_STAGE(PG8_SB(1, 1), b3 + hstepB, voffB);
            PG8_WAIT_V(6); PG8_BAR; PG8_MMA(1, 1, At, B1); PG8_BAR;
            }
        }
        if constexpr (ALIGN_EPI) { if (wr == 0) PG8_BAR; }
        if constexpr (!Epi::AFTER_DRAIN) { E(acc, cur, wr, wc, fr, fq); S.done(cur); }
        if (!has_next) break;
#pragma unroll
        for (int a = 0; a < 2; ++a)
#pragma unroll
            for (int b = 0; b < 2; ++b)
#pragma unroll
                for (int m = 0; m < 4; ++m)
#pragma unroll
                    for (int n = 0; n < 2; ++n) acc[a][b][m][n] = (f32x4){0.f, 0.f, 0.f, 0.f};
        cur = nxt; cA = nA; cB = nB; ++ui;
        if constexpr (ALIGN_EPI) { if (wr == 1) PG8_BAR; }
    }
    PG8_WAIT_V(0);
    if constexpr (!ALIGN_EPI) { if (wr == 0) PG8_BAR; }
    PG8_BAR;
    if constexpr (Epi::AFTER_DRAIN) { E.fused(acc, cur, wr, wc, fr, fq, lds, wid, lane); S.done(cur); }
#undef PG8_SA
#undef PG8_SB
#undef PG8_STAGE
#undef PG8_LDA
#undef PG8_LDB
#undef PG8_MMA
#undef PG8_WAIT_V
#undef PG8_WAIT_L
#undef PG8_BAR
#undef PG8_SCHED
}
}

#include <hip/hip_bf16.h>
#include <cmath>
namespace attn_body {
using bf16=__hip_bfloat16;
using bf16x8=__attribute__((ext_vector_type(8)))short;
using s16x4=__attribute__((ext_vector_type(4)))short;
using f32x16=__attribute__((ext_vector_type(16)))float;
using u32x4=__attribute__((ext_vector_type(4)))unsigned;
constexpr int BATCH=8,NHEAD=16,SEQ=2048,D=64,DM=NHEAD*D;
constexpr int NW=8,QBLK=32,QB=QBLK*NW,KVBLK=64,NQB=SEQ/QB;
constexpr int ATTN_PITCH=DM, ATTN_UNIT_ROWS=QB;
__device__ __forceinline__ int crow(int r,int hi){return (r&3)+8*(r>>2)+4*hi;}
#define SBAR() __builtin_amdgcn_sched_barrier(0)
__device__ __forceinline__ void cmask(f32x16&p0,f32x16&p1,int jb,int qrel,int hi){
  const float NEG=-INFINITY; int kb=64*jb+4*hi;
  #pragma unroll
  for(int r=0;r<16;++r){int kv=kb+(r&3)+8*(r>>2); if(kv>qrel)p0[r]=NEG; if(kv+32>qrel)p1[r]=NEG;}
}

constexpr int NSLOT=3, SLOTB=8192;
constexpr int LDS_K=0, LDS_V=NSLOT*SLOTB, LDS_WS=2*NSLOT*SLOTB, LDS_OST=LDS_WS+NW*64*4, LDS_BYTES=LDS_OST+NW*4096;
constexpr float C2=0.125f*1.4426950408889634f;
__device__ __forceinline__ void glds16(const void*gsrc,unsigned lds_dst){unsigned keep;
  asm volatile("s_mov_b32 %0, m0\n\ts_mov_b32 m0, %2\n\ts_nop 0\n\tglobal_load_lds_dwordx4 %1, off\n\ts_mov_b32 m0, %0":"=&s"(keep):"v"(gsrc),"s"(lds_dst):"memory");}
__device__ __forceinline__ float max3f(float a,float b,float c){float r;asm("v_max3_f32 %0, %1, %2, %3":"=v"(r):"v"(a),"v"(b),"v"(c));return r;}
__device__ __forceinline__ float max2f(float a,float b){float r;asm("v_max_f32_e32 %0, %1, %2":"=v"(r):"v"(a),"v"(b));return r;}
__device__ __forceinline__ float fadd_s(float a,float b){float r;asm("v_add_f32_e32 %0, %1, %2":"=v"(r):"v"(a),"v"(b));return r;}
__device__ __forceinline__ float fsub_s(float a,float b){float r;asm("v_sub_f32_e32 %0, %1, %2":"=v"(r):"v"(a),"v"(b));return r;}
typedef float f32x2_t __attribute__((ext_vector_type(2))); typedef __bf16 bf16x2_t __attribute__((ext_vector_type(2)));
__device__ __forceinline__ unsigned cvtpk_s(float lo,float hi){f32x2_t v={lo,hi};bf16x2_t b=__builtin_convertvector(v,bf16x2_t);return __builtin_bit_cast(unsigned,b);}
#define WAIT_BAR(N) asm volatile("s_waitcnt vmcnt(" #N ") lgkmcnt(0)\n\ts_barrier":::"memory")

__device__ __forceinline__ void qkt(f32x16&p0,f32x16&p1,const char*Kslot,const bf16x8*qr,int r32,int hi){
  const char*kb=Kslot+hi*1024+r32*16;
  #pragma unroll
  for(int d0=0;d0<4;++d0){
    const bf16x8 b0=*reinterpret_cast<const bf16x8*>(kb+d0*2048);
    const bf16x8 b1=*reinterpret_cast<const bf16x8*>(kb+d0*2048+512);
    if(d0==0){p0=__builtin_amdgcn_mfma_f32_32x32x16_bf16(b0,qr[0],p0,0,0,0);p1=__builtin_amdgcn_mfma_f32_32x32x16_bf16(b1,qr[0],p1,0,0,0);}
    else{p0=__builtin_amdgcn_mfma_f32_32x32x16_bf16(b0,qr[d0],p0,0,0,0);p1=__builtin_amdgcn_mfma_f32_32x32x16_bf16(b1,qr[d0],p1,0,0,0);}}
}
typedef __attribute__((address_space(3))) const char* lds_cptr;
typedef short v4i16_t __attribute__((ext_vector_type(4)));
__device__ __forceinline__ void kload8(bf16x8*kf,lds_cptr kp){
  kf[0]=*(const __attribute__((address_space(3))) bf16x8*)(kp);      kf[1]=*(const __attribute__((address_space(3))) bf16x8*)(kp+512);
  kf[2]=*(const __attribute__((address_space(3))) bf16x8*)(kp+2048); kf[3]=*(const __attribute__((address_space(3))) bf16x8*)(kp+2560);
  kf[4]=*(const __attribute__((address_space(3))) bf16x8*)(kp+4096); kf[5]=*(const __attribute__((address_space(3))) bf16x8*)(kp+4608);
  kf[6]=*(const __attribute__((address_space(3))) bf16x8*)(kp+6144); kf[7]=*(const __attribute__((address_space(3))) bf16x8*)(kp+6656);
}
__device__ __forceinline__ void kload2(bf16x8*kf,lds_cptr kp,int j){ kf[2*j]=*(const __attribute__((address_space(3))) bf16x8*)(kp+j*2048); kf[2*j+1]=*(const __attribute__((address_space(3))) bf16x8*)(kp+j*2048+512); }
__device__ __forceinline__ s16x4 vtr(lds_cptr p){ return __builtin_bit_cast(s16x4,__builtin_amdgcn_ds_read_tr16_b64_v4i16((__attribute__((address_space(3))) v4i16_t*)p)); }
__device__ __forceinline__ float rowmax(const f32x16&p0,const f32x16&p1){
  float a=max3f(p0[0],p0[1],p1[0]),b=max3f(p0[2],p0[3],p1[1]);a=max3f(a,p1[2],p1[3]);
  #pragma unroll
  for(int r=4;r<16;r+=4){a=max3f(a,p0[r],p0[r+1]);b=max3f(b,p0[r+2],p0[r+3]);a=max3f(a,p1[r],p1[r+1]);b=max3f(b,p1[r+2],p1[r+3]);}
  const float m=max2f(a,b);
  auto rr=__builtin_amdgcn_permlane32_swap(__float_as_uint(m),__float_as_uint(m),false,false);
  return max2f(__uint_as_float(rr[0]),__uint_as_float(rr[1]));
}
__device__ __forceinline__ void pv(f32x16*o,int vb,bf16x8 pa0,bf16x8 pa1,bf16x8 pa2,bf16x8 pa3){
  #pragma unroll
  for(int d0=0;d0<2;++d0){s16x4 lo[4],hi[4];
    #pragma unroll
    for(int ks=0;ks<4;++ks){
      asm volatile("ds_read_b64_tr_b16 %0,%1 offset:%c2":"=&v"(lo[ks]):"v"(vb),"i"(d0*4096+ks*1024):"memory");
      asm volatile("ds_read_b64_tr_b16 %0,%1 offset:%c2":"=&v"(hi[ks]):"v"(vb),"i"(d0*4096+ks*1024+512):"memory");}
    asm volatile("s_waitcnt lgkmcnt(0)":::"memory");SBAR();
    #define PK(k) (bf16x8){lo[k][0],lo[k][1],lo[k][2],lo[k][3],hi[k][0],hi[k][1],hi[k][2],hi[k][3]}
    o[d0]=__builtin_amdgcn_mfma_f32_32x32x16_bf16(pa0,PK(0),o[d0],0,0,0);
    o[d0]=__builtin_amdgcn_mfma_f32_32x32x16_bf16(pa1,PK(1),o[d0],0,0,0);
    o[d0]=__builtin_amdgcn_mfma_f32_32x32x16_bf16(pa2,PK(2),o[d0],0,0,0);
    o[d0]=__builtin_amdgcn_mfma_f32_32x32x16_bf16(pa3,PK(3),o[d0],0,0,0);
    #undef PK
  }
}

#ifndef ATTN_STORE16
#define ATTN_STORE16(p,v) (*(u32x4*)(p)=(v))
#endif
template<int THRL> __device__ __forceinline__ void attn_unit(int b,int h,int qb,const bf16*Q,const bf16*__restrict__ K,const bf16*__restrict__ V,bf16*O,char*shm,int csl_off){
  const int tid=tid_opaque(),lane=tid&63,r32=lane&31,hi=lane>>5; const int wid=__builtin_amdgcn_readfirstlane(tid>>6);
  const long rowbase=(long)b*SEQ; const int q0=qb*QB;
  const bf16*Qw=Q+(rowbase+q0+wid*QBLK)*DM+h*D;
  const bf16*Kh=K+rowbase*DM+h*D,*Vh=V+rowbase*DM+h*D;
  const unsigned lds0=(unsigned)(uintptr_t)shm;
  float*wsf=(float*)(shm+LDS_WS)+wid*64;
  const bf16*ksrc=Kh+(long)lane*DM+wid*8;
  const bf16*vsrc=Vh+(long)(16*(wid&3)+(lane>>2))*DM+(wid>>2)*32+(lane&3)*8;
  const unsigned kdst=lds0+LDS_K+wid*1024, vdst=lds0+LDS_V+wid*1024;
  #define DMA_K(t,slot) glds16(ksrc+(long)(t)*KVBLK*DM,(unsigned)__builtin_amdgcn_readfirstlane(kdst+(slot)))
  #define DMA_V(t,slot) glds16(vsrc+(long)(t)*KVBLK*DM,(unsigned)__builtin_amdgcn_readfirstlane(vdst+(slot)))
  const int vb0=(int)(lds0+LDS_V)+((lane>>4)&1)*32+(lane&3)*8+(4*hi+((lane&15)>>2))*64;
  const char*Kbase=shm+LDS_K; bf16x8 kf[8];
  const lds_cptr shm3=(lds_cptr)shm; const lds_cptr kp0=shm3+LDS_K+hi*1024+r32*16; const lds_cptr vp0=shm3+LDS_V+((lane>>4)&1)*32+(lane&3)*8+(4*hi+((lane&15)>>2))*64;
  const int NT=(q0+QB)/KVBLK;
  DMA_K(0,0);DMA_V(0,0);DMA_K(1,SLOTB);
  bf16x8 qr[4];
  #pragma unroll
  for(int d0=0;d0<4;++d0)qr[d0]=*reinterpret_cast<const bf16x8*>(&Qw[(long)r32*DM+d0*16+hi*8]);
  float mhat=0.f,l_reg=0.f;f32x16 o[2];o[0]=f32x16{};o[1]=f32x16{};
  typedef float f32x4_t __attribute__((ext_vector_type(4)));
  const __attribute__((address_space(3))) float* csl3=(const __attribute__((address_space(3))) float*)((lds_cptr)shm+csl_off);
  float nbase=csl3[q0+wid*QBLK+r32];
  #define BIASFILL(C0,C1,t) do{ const __attribute__((address_space(3))) float* cp_=csl3+(t)*KVBLK+4*hi; const f32x4_t nb4_={nbase,nbase,nbase,nbase}; \
    _Pragma("unroll") for(int g_=0;g_<4;++g_){ const f32x4_t a_=*(const __attribute__((address_space(3))) f32x4_t*)(cp_+8*g_); const f32x4_t b_=*(const __attribute__((address_space(3))) f32x4_t*)(cp_+32+8*g_); \
      const f32x4_t ta_=nb4_-a_, tb_=nb4_-b_; \
      _Pragma("unroll") for(int e_=0;e_<4;++e_){ C0[4*g_+e_]=ta_[e_]; C1[4*g_+e_]=tb_[e_]; } } }while(0)
  const int qrel=wid*QBLK+r32;
  #define CMASK(P0,P1,t) do{int jb_=(t)-(NT-4); if(jb_>=0)cmask(P0,P1,jb_,qrel,hi);}while(0)
  bool resc=false;
  #define START(P0,P1) do{ const float rm=rowmax(P0,P1); resc=false; \
    { const float dl=rm; mhat=fadd_s(mhat,dl); \
      _Pragma("unroll") for(int r=0;r<16;++r){P0[r]=fsub_s(P0[r],dl);P1[r]=fsub_s(P1[r],dl);} \
      nbase=fsub_s(nbase,dl); } \
    _Pragma("unroll") for(int r=0;r<16;++r)P0[r]=__builtin_amdgcn_exp2f(P0[r]); }while(0)
  #define RESC() do{ if(resc){ asm volatile("s_waitcnt lgkmcnt(0)":::"memory"); \
      _Pragma("unroll") for(int d_=0;d_<2;++d_) _Pragma("unroll") for(int r=0;r<16;++r)o[d_][r]*=wsf[crow(r,hi)]; } }while(0)
  f32x16 pA0,pA1,pB0,pB1;
  int sl_prev=0,sl_cur=0,sl_next=SLOTB;
  #define ROT() do{sl_prev=sl_cur;sl_cur=sl_next;sl_next=(sl_next==(NSLOT-1)*SLOTB)?0:sl_next+SLOTB;}while(0)
  DMA_K(2,2*SLOTB);
  WAIT_BAR(3);
  BIASFILL(pA0,pA1,0);
  qkt(pA0,pA1,Kbase,qr,r32,hi);asm volatile("s_nop 15\n\ts_nop 7":"+v"(pA0),"+v"(pA1));CMASK(pA0,pA1,0);
  START(pA0,pA1);
  BIASFILL(pB0,pB1,1);
  _Pragma("unroll") for(int r=0;r<16;++r)pA1[r]=__builtin_amdgcn_exp2f(pA1[r]);
  WAIT_BAR(0);
  DMA_K(3,0);DMA_V(1,SLOTB);
  ROT();
  kload8(kf,kp0+sl_cur);
  WAIT_BAR(2);
  s16x4 vlo[8],vhi[8]; u32x4 pw0,pw1,pw2,pw3;
  #define PKW(P,B) cvtpk_s(P[B],P[B+1])
  #define PAF(k) __builtin_bit_cast(bf16x8,pw##k)
  #define VFR(i) (bf16x8){vlo[i][0],vlo[i][1],vlo[i][2],vlo[i][3],vhi[i][0],vhi[i][1],vhi[i][2],vhi[i][3]}
  #define PIN(x) asm volatile("":"+v"(x))
  #define MX3(a,b,c) __builtin_fmaxf(__builtin_fmaxf((a),(b)),(c))
  #define GAPA(MF,A0,A1,A2,A3,W0,W1,PW) do{ MF; sacc+=A0; sacc+=A1; sacc+=A2; sacc+=A3; PIN(sacc); W0; W1; PIN(PW); SBAR(); }while(0)
  #define EX(v) __builtin_amdgcn_exp2f(v)
  #define GAPB(MF,X,B) do{ MF; X[B]=EX(X[B]); X[B+1]=EX(X[B+1]); X[B+2]=EX(X[B+2]); X[B+3]=EX(X[B+3]); PIN(X); SBAR(); }while(0)
  #define VRD(i) do{ vlo[i]=vtr(vp_+(((i)>>2)*4096+((i)&3)*1024)); vhi[i]=vtr(vp_+(((i)>>2)*4096+((i)&3)*1024+512)); }while(0)
  #define KRD(G,j) do{ if(G){ kload2(kf,kp0+sl_next,j); SBAR(); } }while(0)
  #define STEP(C0,C1,P0,P1,t,GK,GV,GL) do{ SBAR(); \
    const lds_cptr vp_=vp0+sl_prev; \
    VRD(0); SBAR(); float sacc=(P0[0]+P0[1]); \
    GAPA(C0=__builtin_amdgcn_mfma_f32_32x32x16_bf16(kf[0],qr[0],C0,0,0,0), P0[2],P0[3],P0[4],P0[5],     pw0[0]=PKW(P0,0), pw0[1]=PKW(P0,2), pw0); \
    VRD(4); SBAR(); GAPA(C1=__builtin_amdgcn_mfma_f32_32x32x16_bf16(kf[1],qr[0],C1,0,0,0), P0[6],P0[7],P0[8],P0[9],     pw0[2]=PKW(P0,4), pw0[3]=PKW(P0,6), pw0); \
    VRD(1); SBAR(); GAPA(C0=__builtin_amdgcn_mfma_f32_32x32x16_bf16(kf[2],qr[1],C0,0,0,0),   P0[10],P0[11],P0[12],P0[13], pw1[0]=PKW(P0,8), pw1[1]=PKW(P0,10), pw1); \
    VRD(5); SBAR(); GAPA(C1=__builtin_amdgcn_mfma_f32_32x32x16_bf16(kf[3],qr[1],C1,0,0,0),   P0[14],P0[15],P1[0],P1[1],   pw1[2]=PKW(P0,12),pw1[3]=PKW(P0,14), pw1); \
    VRD(2); SBAR(); GAPA(C0=__builtin_amdgcn_mfma_f32_32x32x16_bf16(kf[4],qr[2],C0,0,0,0),   P1[2],P1[3],P1[4],P1[5],     pw2[0]=PKW(P1,0), pw2[1]=PKW(P1,2), pw2); \
    VRD(6); SBAR(); GAPA(C1=__builtin_amdgcn_mfma_f32_32x32x16_bf16(kf[5],qr[2],C1,0,0,0),   P1[6],P1[7],P1[8],P1[9],     pw2[2]=PKW(P1,4), pw2[3]=PKW(P1,6), pw2); \
    VRD(3); SBAR(); GAPA(C0=__builtin_amdgcn_mfma_f32_32x32x16_bf16(kf[6],qr[3],C0,0,0,0),   P1[10],P1[11],P1[12],P1[13], pw3[0]=PKW(P1,8), pw3[1]=PKW(P1,10), pw3); \
    VRD(7); SBAR(); GAPA(C1=__builtin_amdgcn_mfma_f32_32x32x16_bf16(kf[7],qr[3],C1,0,0,0),   P1[14],P1[15],0.f,0.f,       pw3[2]=PKW(P1,12),pw3[3]=PKW(P1,14), pw3); \
    l_reg+=sacc; \
    if(GK){DMA_K((t)+3,sl_cur);} if(GV){DMA_V((t)+1,sl_next);} \
    CMASK(C0,C1,t); \
    { float a=MX3(C0[0],C0[1],C1[0]),b=MX3(C0[2],C0[3],C1[1]); a=MX3(a,C1[2],C1[3]); \
      _Pragma("unroll") for(int r=4;r<16;r+=4){a=MX3(a,C0[r],C0[r+1]);b=MX3(b,C0[r+2],C0[r+3]);a=MX3(a,C1[r],C1[r+1]);b=MX3(b,C1[r+2],C1[r+3]);} \
      float rm=__builtin_fmaxf(a,b); { auto rr=__builtin_amdgcn_permlane32_swap(__float_as_uint(rm),__float_as_uint(rm),false,false); rm=__builtin_fmaxf(__uint_as_float(rr[0]),__uint_as_float(rr[1])); } \
      resc=false; \
      if(__builtin_expect(__any(rm>(float)THRL),0)){ const float dl=__builtin_fmaxf(rm,0.f); mhat+=dl; \
        _Pragma("unroll") for(int r=0;r<16;++r){C0[r]-=dl;C1[r]-=dl;} \
        nbase-=dl; \
        const float f=__builtin_amdgcn_exp2f(-dl); l_reg*=f; if(hi==0)wsf[r32]=f; resc=true; } } \
    SBAR(); \
    GAPB(o[0]=__builtin_amdgcn_mfma_f32_32x32x16_bf16(PAF(0),VFR(0),o[0],0,0,0), C0,0); \
    GAPB(o[1]=__builtin_amdgcn_mfma_f32_32x32x16_bf16(PAF(0),VFR(4),o[1],0,0,0), C0,4); \
    KRD(GL,0); GAPB(o[0]=__builtin_amdgcn_mfma_f32_32x32x16_bf16(PAF(1),VFR(1),o[0],0,0,0), C0,8); \
    KRD(GL,1); GAPB(o[1]=__builtin_amdgcn_mfma_f32_32x32x16_bf16(PAF(1),VFR(5),o[1],0,0,0), C0,12); \
    KRD(GL,2); GAPB(o[0]=__builtin_amdgcn_mfma_f32_32x32x16_bf16(PAF(2),VFR(2),o[0],0,0,0), C1,0); \
    KRD(GL,3); GAPB(o[1]=__builtin_amdgcn_mfma_f32_32x32x16_bf16(PAF(2),VFR(6),o[1],0,0,0), C1,4); \
    GAPB(o[0]=__builtin_amdgcn_mfma_f32_32x32x16_bf16(PAF(3),VFR(3),o[0],0,0,0), C1,8); \
    GAPB(o[1]=__builtin_amdgcn_mfma_f32_32x32x16_bf16(PAF(3),VFR(7),o[1],0,0,0), C1,12); \
    if(GV){ BIASFILL(P0,P1,(t)+1); } \
    }while(0)
  int t=1;
  #undef CMASK
  #define CMASK(P0,P1,t) do{}while(0)
  for(;t+5<NT;t+=2){
    STEP(pB0,pB1,pA0,pA1,t,true,true,true);     WAIT_BAR(2); RESC(); ROT();
    STEP(pA0,pA1,pB0,pB1,t+1,true,true,true);   WAIT_BAR(2); RESC(); ROT();
  }
  #undef CMASK
  #define CMASK(P0,P1,t) do{int jb_=(t)-(NT-4); if(jb_>=0)cmask(P0,P1,jb_,qrel,hi);}while(0)
  #define ENDW(tt) do{ if((tt)+3<NT){WAIT_BAR(2);} else if((tt)+2<NT){WAIT_BAR(1);} else {WAIT_BAR(0);} }while(0)
  for(;t+1<NT;t+=2){
    STEP(pB0,pB1,pA0,pA1,t,(t+3<NT),(t+1<NT),(t+1<NT));       ENDW(t);   RESC(); ROT();
    STEP(pA0,pA1,pB0,pB1,t+1,(t+4<NT),(t+2<NT),(t+2<NT));     ENDW(t+1); RESC(); ROT();
  }
  STEP(pB0,pB1,pA0,pA1,NT-1,false,false,false); RESC();
  { float sacc=pB0[0]+pB0[1]; _Pragma("unroll") for(int r=2;r<16;++r)sacc+=pB0[r]; _Pragma("unroll") for(int r=0;r<16;++r)sacc+=pB1[r]; l_reg+=sacc;
    pw0=(u32x4){PKW(pB0,0),PKW(pB0,2),PKW(pB0,4),PKW(pB0,6)};pw1=(u32x4){PKW(pB0,8),PKW(pB0,10),PKW(pB0,12),PKW(pB0,14)};pw2=(u32x4){PKW(pB1,0),PKW(pB1,2),PKW(pB1,4),PKW(pB1,6)};pw3=(u32x4){PKW(pB1,8),PKW(pB1,10),PKW(pB1,12),PKW(pB1,14)};
    SBAR(); pv(o,vb0+sl_cur,PAF(0),PAF(1),PAF(2),PAF(3)); }
  #undef PKW
  #undef PAF
  #undef VFR
  #undef PIN
  #undef MX3
  #undef GAPA
  #undef GAPB
  #undef EX
  #undef VRD
  #undef KRD
  #undef STEP
  #undef ENDW
  {auto rr=__builtin_amdgcn_permlane32_swap(__float_as_uint(l_reg),__float_as_uint(l_reg),false,false);l_reg=__uint_as_float(rr[0])+__uint_as_float(rr[1]);}
  if(hi==0)wsf[32+r32]=l_reg;asm volatile("s_waitcnt lgkmcnt(0)":::"memory");
  float rli[16];
  #pragma unroll
  for(int r=0;r<16;++r)rli[r]=__builtin_amdgcn_rcpf(wsf[32+crow(r,hi)]);
  bf16*Ow=O+(rowbase+q0+wid*QBLK)*DM+h*D;
  { bf16*stg=(bf16*)(shm+LDS_OST)+wid*2048;
    #pragma unroll
    for(int r=0;r<16;++r){const int orow=crow(r,hi);
      #pragma unroll
      for(int d0=0;d0<2;++d0)stg[orow*64+d0*32+r32]=__float2bfloat16(o[d0][r]*rli[r]);}
    asm volatile("s_waitcnt lgkmcnt(0)":::"memory");
    #pragma unroll
    for(int i=0;i<4;++i){const int row=i*8+(lane>>3),ch=lane&7; const u32x4 v=*(const u32x4*)(stg+row*64+ch*8); ATTN_STORE16(Ow+(long)row*DM+ch*8,v);} }
  asm volatile("s_waitcnt lgkmcnt(0)\n\ts_barrier":::"memory");
  #undef BIASFILL
  #undef DMA_K
  #undef DMA_V
  #undef CMASK
  #undef START
  #undef RESC
  #undef ROT
}
constexpr int ATTN_LDS_BYTES=LDS_BYTES;
struct AttnTensors { const bf16* Q; const bf16* K; const bf16* V; bf16* O; };
struct AttnUnit { int bh; int qb; };
struct StaticOrder {
  int vcu;
  __device__ __forceinline__ explicit StaticOrder(int grid,int block):vcu((block%8)*(grid/8)+block/8){}
  __device__ __forceinline__ bool next(int i,AttnUnit&u)const{ if(i>=4)return false; const int s=2*(vcu&1); u.bh=vcu>>1; u.qb=(i==0)?s:(i==1)?7-s:(i==2)?s+1:6-s; return true; }
  __device__ __forceinline__ void a_ready(const AttnUnit&)const{}
  __device__ __forceinline__ void done(const AttnUnit&)const{}
};
template<class Sched,int THRL=8> __device__ __forceinline__ void attn_phase(char*lds,const AttnTensors&T,const Sched&S,int csl_off){
  AttnUnit u;
  for(int i=0;S.next(i,u);++i){ S.a_ready(u); attn_unit<THRL>(u.bh/NHEAD,u.bh%NHEAD,u.qb,T.Q,T.K,T.V,T.O,lds,csl_off); S.done(u); }
}
#undef SBAR
#undef WAIT_BAR
}

#define GAS __attribute__((address_space(1)))
#define LAS __attribute__((address_space(3)))
typedef unsigned v4u __attribute__((ext_vector_type(4)));
typedef GAS unsigned gu32;
typedef GAS unsigned long long gu64;
#define RLX_AGENT __ATOMIC_RELAXED, __HIP_MEMORY_SCOPE_AGENT
#define LDS_WAIT() asm volatile("s_waitcnt lgkmcnt(0)" ::: "memory")
#define VM_WAIT() asm volatile("s_waitcnt vmcnt(0)" ::: "memory")
__device__ __forceinline__ unsigned long long rt() { return __builtin_amdgcn_s_memrealtime(); }

#define XB_TMO      128
#define XB_XCNT(j)  (256  + 64 * (j))
#define XB_XSUB(j)  (1280 + 64 * (j))
#define XB_XGEN(j)  (2304 + 64 * (j))
#define XB_TOP      3328
#define XB_TOPGEN   3392
#define XCD_BAR_WORDS 3456
#define XB_SPIN_CAP (1u << 18)

__device__ __forceinline__ unsigned xb_ld(unsigned* p)              { return __hip_atomic_load(p, __ATOMIC_RELAXED, __HIP_MEMORY_SCOPE_AGENT); }
__device__ __forceinline__ unsigned xb_add(unsigned* p, unsigned v) { return __hip_atomic_fetch_add(p, v, __ATOMIC_RELAXED, __HIP_MEMORY_SCOPE_AGENT); }
__device__ __forceinline__ unsigned xb_xcc_id() { return (unsigned)__builtin_amdgcn_s_getreg((3 << 11) | 20) & 0xFu; }
#define XB_SPIN(cond, bar) do { unsigned _sp = 0; while (cond) { __builtin_amdgcn_s_sleep(1); \
    if ((++_sp & 255u) == 0u) { if (xb_ld(&(bar)[XB_TMO])) break; if (_sp > XB_SPIN_CAP) { atomicAdd(&(bar)[XB_TMO], 1u); break; } } } } while (0)

struct XcdBarrier {
    unsigned* bar; unsigned x;
    volatile LAS unsigned* st;
};

__device__ __forceinline__ XcdBarrier xcd_barrier_post(unsigned* bar, volatile LAS unsigned* st) {
    XcdBarrier b; b.bar = bar; b.x = xb_xcc_id(); b.st = st;
    if (threadIdx.x == 0) (void)xb_add(&bar[XB_XCNT(b.x)], 1u);
    return b;
}
__device__ __forceinline__ void xcd_barrier_complete(unsigned* bar, unsigned x, unsigned& nloc, unsigned& nx) {
    const unsigned G = gridDim.x * gridDim.y * gridDim.z;
    unsigned sum, cnt, mine, sp = 0u;
    for (;;) {
        sum = 0u; cnt = 0u; mine = 0u;
#pragma unroll
        for (unsigned j = 0; j < 16; ++j) { const unsigned c = xb_ld(&bar[XB_XCNT(j)]); sum += c; cnt += (c > 0u) ? 1u : 0u; mine = (j == x) ? c : mine; }
        if (sum == G) break;
        __builtin_amdgcn_s_sleep(1);
        if ((++sp & 255u) == 0u) { if (xb_ld(&bar[XB_TMO])) break; if (sp > XB_SPIN_CAP) { atomicAdd(&bar[XB_TMO], 1u); break; } }
    }
    nloc = mine > 0u ? mine : 1u; nx = cnt > 0u ? cnt : 1u;
}

__device__ __forceinline__ void xcd_barrier(const XcdBarrier& b) {
    asm volatile("s_waitcnt vmcnt(0)" ::: "memory");
    __syncthreads();
    if (threadIdx.x == 0) {
        unsigned* bar = b.bar;
        __builtin_amdgcn_s_waitcnt(0);
        unsigned nloc = b.st[0], nx = b.st[1];
        if (nloc == 0u) { xcd_barrier_complete(bar, b.x, nloc, nx); b.st[0] = nloc; b.st[1] = nx; }
        const unsigned old = xb_add(&bar[XB_XSUB(b.x)], 1u);
        const unsigned gen = old / nloc;
        if (old + 1u == (gen + 1u) * nloc) {
            __builtin_amdgcn_fence(__ATOMIC_RELEASE, "agent");
            asm volatile("s_waitcnt vmcnt(0)" ::: "memory");
            const unsigned og = xb_add(&bar[XB_TOP], 1u);
            const unsigned tg = og / nx;
            if (og + 1u == (tg + 1u) * nx) xb_add(&bar[XB_TOPGEN], 1u);
            else XB_SPIN(xb_ld(&bar[XB_TOPGEN]) == tg, bar);
            __builtin_amdgcn_fence(__ATOMIC_ACQUIRE, "agent");
            xb_add(&bar[XB_XGEN(b.x)], 1u);
            asm volatile("s_waitcnt vmcnt(0)" ::: "memory");
        } else {
            XB_SPIN(xb_ld(&bar[XB_XGEN(b.x)]) == gen, bar);
            __builtin_amdgcn_fence(__ATOMIC_ACQUIRE, "agent");
            asm volatile("s_waitcnt vmcnt(0)" ::: "memory");
        }
    }
    __syncthreads();
}


typedef float f32x16 __attribute__((ext_vector_type(16)));
constexpr int NWAVES_ = 8;
struct WgAcc { f32x4 t[2][2]; };
struct WgFrag { bf16x8 a[2][2], b[2][2]; };
__device__ __forceinline__ void wg_load(WgFrag& f, const char* ap, const char* bp, size_t a16, size_t b16, int batch) {
#pragma unroll
    for (int t = 0; t < 2; ++t)
#pragma unroll
        for (int ks = 0; ks < 2; ++ks) { f.a[t][ks] = *(const bf16x8*)(ap + t * a16 + 128 * batch + 64 * ks); f.b[t][ks] = *(const bf16x8*)(bp + t * b16 + 128 * batch + 64 * ks); }
}
__device__ __forceinline__ void wg_mma(WgAcc& acc, const WgFrag& f) {
#pragma unroll
    for (int ks = 0; ks < 2; ++ks)
#pragma unroll
        for (int tm = 0; tm < 2; ++tm)
#pragma unroll
            for (int tn = 0; tn < 2; ++tn) acc.t[tm][tn] = __builtin_amdgcn_mfma_f32_16x16x32_bf16(f.b[tn][ks], f.a[tm][ks], acc.t[tm][tn], 0, 0, 0);
}
__device__ __forceinline__ void wave_gemm32(WgAcc& acc, const bf16_t* A, int lda, int row0, const bf16_t* Bt, int ldb, int col0, int ncolvalid, int k0, int klen, int lane) {
    const int fr = lane & 15, fq = lane >> 4;
    const char* ap = (const char*)(A + (size_t)(row0 + fr) * lda + k0) + 16 * fq;
    const char* bp = (const char*)(Bt + (size_t)(col0 + fr) * ldb + k0) + 16 * fq;
    const size_t a16 = (size_t)16 * lda * 2, b16 = ncolvalid > 16 ? (size_t)16 * ldb * 2 : 0;
    int nB = klen / 64; asm volatile("" : "+s"(nB));
    WgFrag X, Y, Z;
    wg_load(X, ap, bp, a16, b16, 0); wg_load(Y, ap, bp, a16, b16, 1);
#pragma unroll 1
    for (int S = 0; S < nB; S += 3) {
        if (S + 2 < nB) wg_load(Z, ap, bp, a16, b16, S + 2);
        wg_mma(acc, X);
        if (S + 3 < nB) wg_load(X, ap, bp, a16, b16, S + 3);
        if (S + 1 < nB) wg_mma(acc, Y);
        if (S + 4 < nB) wg_load(Y, ap, bp, a16, b16, S + 4);
        if (S + 2 < nB) wg_mma(acc, Z);
    }
}
template <class F> __device__ __forceinline__ void wave_epi32(const WgAcc& acc, int row0, int col0, int lane, const F& f) {
    const int fr = lane & 15, fq = lane >> 4;
#pragma unroll
    for (int tm = 0; tm < 2; ++tm)
#pragma unroll
        for (int tn = 0; tn < 2; ++tn) f(row0 + 16 * tm + fr, col0 + 16 * tn + 4 * fq, acc.t[tm][tn]);
}
__device__ __forceinline__ WgAcc wg_zero() { WgAcc a;
#pragma unroll
    for (int tm = 0; tm < 2; ++tm)
#pragma unroll
        for (int tn = 0; tn < 2; ++tn) a.t[tm][tn] = (f32x4){0.f, 0.f, 0.f, 0.f};
    return a; }


struct WsA { bf16x8 a[2][2]; };
__device__ __forceinline__ void ws_loadA(WsA& f, const char* ap, size_t a16, int batch) {
#pragma unroll
    for (int t = 0; t < 2; ++t)
#pragma unroll
        for (int ks = 0; ks < 2; ++ks) f.a[t][ks] = *(const bf16x8*)(ap + t * a16 + 128 * batch + 64 * ks);
}
__device__ __forceinline__ void ws_mma(WgAcc& acc, const WsA& f, const unsigned char* sB, int pitch, int fr, int fq, int batch) {
#pragma unroll
    for (int ks = 0; ks < 2; ++ks) { bf16x8 b[2];
#pragma unroll
        for (int tn = 0; tn < 2; ++tn) { const int row = 16 * tn + fr, c = 8 * batch + 4 * ks + fq; b[tn] = *(const bf16x8*)(sB + row * pitch + 16 * (c ^ fr)); }
#pragma unroll
        for (int tm = 0; tm < 2; ++tm)
#pragma unroll
            for (int tn = 0; tn < 2; ++tn) acc.t[tm][tn] = __builtin_amdgcn_mfma_f32_16x16x32_bf16(b[tn], f.a[tm][ks], acc.t[tm][tn], 0, 0, 0); }
}
__device__ __forceinline__ void wg_skinny(WgAcc& acc, unsigned char* sB, const bf16_t* A, int lda, int row0, const bf16_t* Bt, int ldb, int col0, int k0, int klen, int tid, int lane) {
    const int fr = lane & 15, fq = lane >> 4, pitch = klen * 2, cpr = klen / 8;
    __syncthreads();
    for (int ch = tid; ch < 32 * cpr; ch += NWAVES_ * 64) { const int row = ch / cpr, c = ch % cpr;
        *(u32x4*)(sB + row * pitch + 16 * (c ^ (row & 15))) = *(const u32x4*)(Bt + (size_t)(col0 + row) * ldb + k0 + 8 * c); }
    const char* ap = (const char*)(A + (size_t)(row0 + fr) * lda + k0) + 16 * fq; const size_t a16 = (size_t)16 * lda * 2;
    int nB = klen / 64; asm volatile("" : "+s"(nB));
    WsA X0, X1, X2, X3;
    ws_loadA(X0, ap, a16, 0); ws_loadA(X1, ap, a16, 1); ws_loadA(X2, ap, a16, 2);
    __syncthreads();
#pragma unroll 1
    for (int S = 0; S < nB; S += 4) {
        ws_loadA(X3, ap, a16, S + 3);
        ws_mma(acc, X0, sB, pitch, fr, fq, S);
        if (S + 4 < nB) ws_loadA(X0, ap, a16, S + 4);
        ws_mma(acc, X1, sB, pitch, fr, fq, S + 1);
        if (S + 5 < nB) ws_loadA(X1, ap, a16, S + 5);
        ws_mma(acc, X2, sB, pitch, fr, fq, S + 2);
        if (S + 6 < nB) ws_loadA(X2, ap, a16, S + 6);
        ws_mma(acc, X3, sB, pitch, fr, fq, S + 3);
    }
}

constexpr int NWAVES = 8;
constexpr int RING_OFF = 0, RING_BYTES = 131072;
constexpr int LDS_CSL = 86016;
constexpr int LDSCTL_OFF = RING_BYTES, MISC_OFF = LDSCTL_OFF + 320;
constexpr int LDS_BYTES = 147456;
static_assert(attn_body::ATTN_LDS_BYTES <= LDS_CSL && LDS_CSL + NKEY * 4 <= RING_BYTES, "LDS map");
constexpr int CW_BAR = 1024;
constexpr size_t CTL_ZERO_BYTES = 65536;
static_assert((CW_BAR + XCD_BAR_WORDS) * 4 <= (int)CTL_ZERO_BYTES, "ctl");

template <class F> struct EpiElem {
    static constexpr bool PERM = false, AFTER_DRAIN = false; F f;
    __device__ __forceinline__ void operator()(const f32x4 (&acc)[2][2][4][2], const pg8::Unit& u, int wr, int wc, int fr, int fq) const {
        const int row0 = u.pm * 256 + wr * 64 + fr, col0 = u.pn * 256 + wc * 32 + 4 * fq;
#pragma unroll
        for (int ai = 0; ai < 2; ++ai)
#pragma unroll
            for (int m = 0; m < 4; ++m)
#pragma unroll
                for (int bj = 0; bj < 2; ++bj)
#pragma unroll
                    for (int n = 0; n < 2; ++n) f(row0 + ai * 128 + m * 16, col0 + bj * 128 + n * 16, acc[ai][bj][m][n]);
    }
};

template <class F, int REPS = 1> struct EpiElem8 {
    static constexpr bool PERM = true, AFTER_DRAIN = false; F f;
    __device__ __forceinline__ void operator()(const f32x4 (&acc)[2][2][4][2], const pg8::Unit& u, int wr, int wc, int fr, int fq) const {
        const int row0 = u.pm * 256 + wr * 64 + fr, col0 = u.pn * 256 + wc * 32 + 8 * fq;
#pragma unroll
        for (int ai = 0; ai < 2; ++ai)
#pragma unroll
            for (int m = 0; m < 4; ++m)
#pragma unroll
                for (int bj = 0; bj < 2; ++bj) f.op8(row0 + ai * 128 + m * 16, col0 + bj * 128, acc[ai][bj][m][0], acc[ai][bj][m][1]);
        if (REPS > 1) { asm volatile("s_waitcnt vmcnt(0)" ::: "memory");
#pragma unroll
        for (int ai = 0; ai < 2; ++ai)
#pragma unroll
            for (int m = 0; m < 4; ++m)
#pragma unroll
                for (int bj = 0; bj < 2; ++bj) f.op8(row0 + ai * 128 + m * 16, col0 + bj * 128, acc[ai][bj][m][0], acc[ai][bj][m][1]); }
    }
};

template <class F> struct EpiElem8L {
    static constexpr bool PERM = true, AFTER_DRAIN = false; F f;
    __device__ __forceinline__ void operator()(const f32x4 (&acc)[2][2][4][2], const pg8::Unit& u, int wr, int wc, int fr, int fq) const {
        const int row0 = u.pm * 256 + wr * 64 + fr, col0 = u.pn * 256 + wc * 32 + 8 * fq;
#pragma unroll
        for (int ai = 0; ai < 2; ++ai) { typename F::Regs rg[4][2];
#pragma unroll
            for (int m = 0; m < 4; ++m)
#pragma unroll
                for (int bj = 0; bj < 2; ++bj) f.load(rg[m][bj], row0 + ai * 128 + m * 16, col0 + bj * 128);
            asm volatile("" ::: "memory");
#pragma unroll
            for (int m = 0; m < 4; ++m)
#pragma unroll
                for (int bj = 0; bj < 2; ++bj) f.apply(rg[m][bj], row0 + ai * 128 + m * 16, col0 + bj * 128, acc[ai][bj][m][0], acc[ai][bj][m][1]);
            asm volatile("" ::: "memory"); }
    }
};

template <int PER, class Ld> __device__ __forceinline__ void block_cumsum_lds(float* csl, float* wtot, int npos, const Ld& ld) {
    const int tid = tid_opaque(), lane = tid & 63, wave = tid >> 6;
    float v[PER]; float run = 0.f;
#pragma unroll
    for (int e = 0; e < PER; ++e) { const int pos = tid * PER + e; v[e] = pos < npos ? ld(pos) : 0.f; run += v[e]; v[e] = run; }
    const float incl = wave_incl_scan(run, lane), excl = incl - run;
    if (lane == 63) wtot[wave] = incl;
    __syncthreads();
    float off = excl;
#pragma unroll
    for (int w = 0; w < 8; ++w) if (w < wave) off += wtot[w];
#pragma unroll
    for (int e = 0; e < PER; ++e) { const int pos = tid * PER + e; if (pos < npos) csl[pos] = (off + v[e]) * LOG2E; }
    __syncthreads();
}

template <int W> __device__ __forceinline__ void pool_seg16(const Params& p, int row0, int c0) {
    const bf16_t* U = (const bf16_t*)(p.ws + WS_U); bf16_t* PO = (bf16_t*)(p.ws + WS_PO);
    const int t0 = row0 % SEQ;
    u32x4 v[W - 1 + 16];
#pragma unroll
    for (int j = 0; j < W - 1 + 16; ++j) { const int r = j - (W - 1); v[j] = (t0 + r >= 0) ? *(const u32x4*)(U + (size_t)(row0 + r) * PW + c0) : (u32x4){0u, 0u, 0u, 0u}; }
    float s[8];
#pragma unroll
    for (int e = 0; e < 8; ++e) s[e] = 0.f;
#pragma unroll
    for (int j = 0; j < W - 1; ++j) { s[0] += bflo(v[j].x); s[1] += bfhi(v[j].x); s[2] += bflo(v[j].y); s[3] += bfhi(v[j].y); s[4] += bflo(v[j].z); s[5] += bfhi(v[j].z); s[6] += bflo(v[j].w); s[7] += bfhi(v[j].w); }
#pragma unroll
    for (int r = 0; r < 16; ++r) { const u32x4 c = v[r + W - 1], q = v[r]; const int t = t0 + r;
        const float cur[8] = {bflo(c.x), bfhi(c.x), bflo(c.y), bfhi(c.y), bflo(c.z), bfhi(c.z), bflo(c.w), bfhi(c.w)};
        const float old[8] = {bflo(q.x), bfhi(q.x), bflo(q.y), bfhi(q.y), bflo(q.z), bfhi(q.z), bflo(q.w), bfhi(q.w)};
        const float rc = 1.0f / (float)((t + 1 < W) ? t + 1 : W); float o[8];
#pragma unroll
        for (int e = 0; e < 8; ++e) { s[e] += cur[e]; o[e] = s[e] * rc - cur[e]; s[e] -= old[e]; }
        u32x4 ov; ov.x = pk2(o[0], o[1]); ov.y = pk2(o[2], o[3]); ov.z = pk2(o[4], o[5]); ov.w = pk2(o[6], o[7]);
        *(u32x4*)(PO + (size_t)(row0 + r) * PW + c0) = ov; }
}

struct SaKV { f32x4 k[8]; float v[32]; };
__device__ __forceinline__ void sa_load(SaKV& f, const float* kp, const float* vp, int key0) {
#pragma unroll
    for (int bl = 0; bl < 2; ++bl)
#pragma unroll
        for (int ks = 0; ks < 2; ++ks)
#pragma unroll
            for (int hf = 0; hf < 2; ++hf) f.k[(bl * 2 + ks) * 2 + hf] = *(const f32x4*)(kp + (size_t)(key0 + 16 * bl) * (NH * DH) + 32 * ks + 4 * hf);
#pragma unroll
    for (int db = 0; db < 4; ++db)
#pragma unroll
        for (int j = 0; j < 8; ++j) f.v[db * 8 + j] = vp[(size_t)(key0 + (j < 4 ? j : 12 + j)) * (NH * DH) + 16 * db];
}
__device__ __forceinline__ bf16x8 pack8(float a0, float a1, float a2, float a3, float a4, float a5, float a6, float a7) {
    u32x4 w; w.x = pk2(a0, a1); w.y = pk2(a2, a3); w.z = pk2(a4, a5); w.w = pk2(a6, a7); return __builtin_bit_cast(bf16x8, w);
}
__device__ __forceinline__ void sa_step(const SaKV& f, const bf16x8 (&qf)[2], const float* csl, int key0, float ct, int g, float& m, float& l, f32x4 (&o)[4]) {
    f32x4 s[2];
#pragma unroll
    for (int bl = 0; bl < 2; ++bl) { const f32x4 cs = *(const f32x4*)(csl + key0 + 16 * bl + 4 * g); s[bl] = (f32x4){ct - cs.x, ct - cs.y, ct - cs.z, ct - cs.w};
#pragma unroll
        for (int ks = 0; ks < 2; ++ks) { const f32x4 a = f.k[(bl * 2 + ks) * 2], c = f.k[(bl * 2 + ks) * 2 + 1];
            s[bl] = __builtin_amdgcn_mfma_f32_16x16x32_bf16(pack8(a.x, a.y, a.z, a.w, c.x, c.y, c.z, c.w), qf[ks], s[bl], 0, 0, 0); } }
    float mx = fmaxf(fmaxf(fmaxf(s[0].x, s[0].y), fmaxf(s[0].z, s[0].w)), fmaxf(fmaxf(s[1].x, s[1].y), fmaxf(s[1].z, s[1].w)));
    mx = fmaxf(mx, __shfl_xor(mx, 16)); mx = fmaxf(mx, __shfl_xor(mx, 32));
    const float mn = fmaxf(m, mx), alpha = exp2f(m - mn); m = mn;
    float pr[8];
#pragma unroll
    for (int e = 0; e < 4; ++e) { pr[e] = exp2f(s[0][e] - mn); pr[4 + e] = exp2f(s[1][e] - mn); }
    l = l * alpha + ((pr[0] + pr[1]) + (pr[2] + pr[3])) + ((pr[4] + pr[5]) + (pr[6] + pr[7]));
    const bf16x8 pf = pack8(pr[0], pr[1], pr[2], pr[3], pr[4], pr[5], pr[6], pr[7]);
#pragma unroll
    for (int db = 0; db < 4; ++db) { o[db] = o[db] * alpha;
        o[db] = __builtin_amdgcn_mfma_f32_16x16x32_bf16(pack8(f.v[db * 8], f.v[db * 8 + 1], f.v[db * 8 + 2], f.v[db * 8 + 3], f.v[db * 8 + 4], f.v[db * 8 + 5], f.v[db * 8 + 6], f.v[db * 8 + 7]), pf, o[db], 0, 0, 0); }
}
__device__ __forceinline__ void sample_attn(const Params& p, int bh, const float* csl, float* part, bf16_t* AO) {
    const int tid = tid_opaque(), lane = tid & 63, wave = __builtin_amdgcn_readfirstlane(tid >> 6), i = lane & 15, g = lane >> 4, b = bh / NH, h = bh % NH;
    const bf16_t* Q = (const bf16_t*)(p.ws + WS_Q); const bf16_t* Kb = (const bf16_t*)(p.ws + WS_K); const bf16_t* Vb = (const bf16_t*)(p.ws + WS_V);
    bf16x8 qf[2];
#pragma unroll
    for (int ks = 0; ks < 2; ++ks) qf[ks] = *(const bf16x8*)(Q + (size_t)(MP + b * SN + i) * AW + h * DH + 32 * ks + 8 * g);
    const float ct = csl[PAST + i]; float m = -INFINITY, l = 0.f; f32x4 o[4];
#pragma unroll
    for (int db = 0; db < 4; ++db) o[db] = (f32x4){0.f, 0.f, 0.f, 0.f};
    const float* kp = p.ck + (((size_t)b * PAST + i) * NH + h) * DH + 8 * g;
    const float* vp = p.cv + (((size_t)b * PAST + 4 * g) * NH + h) * DH + i;
    const int k0 = wave * 256;
    SaKV X, Y;
    sa_load(X, kp, vp, k0);
#pragma unroll 1
    for (int st = 0; st < 8; st += 2) {
        sa_load(Y, kp, vp, k0 + 32 * (st + 1));
        sa_step(X, qf, csl, k0 + 32 * st, ct, g, m, l, o);
        if (st + 2 < 8) sa_load(X, kp, vp, k0 + 32 * (st + 2));
        sa_step(Y, qf, csl, k0 + 32 * (st + 1), ct, g, m, l, o);
    }
    if (wave == 7) {
        const int r0 = MP + b * SN;
        f32x4 s; { const f32x4 cs = *(const f32x4*)(csl + PAST + 4 * g); s = (f32x4){ct - cs.x, ct - cs.y, ct - cs.z, ct - cs.w}; }
#pragma unroll
        for (int ks = 0; ks < 2; ++ks) s = __builtin_amdgcn_mfma_f32_16x16x32_bf16(*(const bf16x8*)(Kb + (size_t)(r0 + i) * AW + h * DH + 32 * ks + 8 * g), qf[ks], s, 0, 0, 0);
#pragma unroll
        for (int e = 0; e < 4; ++e) if (4 * g + e > i) s[e] = -INFINITY;
        float mx = fmaxf(fmaxf(s.x, s.y), fmaxf(s.z, s.w));
        mx = fmaxf(mx, __shfl_xor(mx, 16)); mx = fmaxf(mx, __shfl_xor(mx, 32));
        const float mn = fmaxf(m, mx), alpha = exp2f(m - mn); m = mn;
        float pr[4];
#pragma unroll
        for (int e = 0; e < 4; ++e) pr[e] = exp2f(s[e] - mn);
        l = l * alpha + ((pr[0] + pr[1]) + (pr[2] + pr[3]));
        const bf16x8 pf = pack8(pr[0], pr[1], pr[2], pr[3], 0.f, 0.f, 0.f, 0.f);
#pragma unroll
        for (int db = 0; db < 4; ++db) { float vv[4];
#pragma unroll
            for (int j = 0; j < 4; ++j) vv[j] = bf2f(Vb[(size_t)(r0 + 4 * g + j) * AW + h * DH + 16 * db + i]);
            o[db] = o[db] * alpha;
            o[db] = __builtin_amdgcn_mfma_f32_16x16x32_bf16(pack8(vv[0], vv[1], vv[2], vv[3], 0.f, 0.f, 0.f, 0.f), pf, o[db], 0, 0, 0); }
    }
    l += __shfl_xor(l, 16); l += __shfl_xor(l, 32);
    float* my = part + (wave * 16 + i) * 66;
#pragma unroll
    for (int db = 0; db < 4; ++db)
#pragma unroll
        for (int e = 0; e < 4; ++e) my[16 * db + 4 * g + e] = o[db][e];
    if (g == 0) { my[64] = m; my[65] = l; }
    __syncthreads();
    { const int i2 = tid & 15, dg = tid >> 4;
        float M = -INFINITY;
#pragma unroll
        for (int w = 0; w < 8; ++w) M = fmaxf(M, part[(w * 16 + i2) * 66 + 64]);
        float L = 0.f, a0 = 0.f, a1 = 0.f;
#pragma unroll
        for (int w = 0; w < 8; ++w) { const float* pw_ = part + (w * 16 + i2) * 66; const float f = exp2f(pw_[64] - M); L += f * pw_[65]; a0 += f * pw_[2 * dg]; a1 += f * pw_[2 * dg + 1]; }
        const float rl = 1.f / L;
        *(unsigned*)(AO + (size_t)(MP + b * SN + i2) * AW + h * DH + 2 * dg) = pk2(a0 * rl, a1 * rl);
    }
    __syncthreads();
}

#ifndef PROBE_MASK
#define PROBE_MASK 0
#endif
__global__ void __launch_bounds__(NWAVES * 64, 2) mega_fwd(Params p) {
    extern __shared__ __attribute__((aligned(16))) unsigned char lds[];
    LAS unsigned char* ldsl = (LAS unsigned char*)lds;
    volatile LAS unsigned* MISC = (volatile LAS unsigned*)(ldsl + MISC_OFF);
    const int G = gridDim.x, bx = blockIdx.x, vcu = (G % 8 == 0) ? (bx % 8) * (G / 8) + bx / 8 : bx;
    gu32* ctl = (gu32*)(p.ws + WS_CTL);
    for (int u = threadIdx.x; u < (LDS_BYTES - LDSCTL_OFF) / 4; u += NWAVES * 64) ((LAS unsigned*)(ldsl + LDSCTL_OFF))[u] = 0u;
    __syncthreads();
    const bool one = (p.ph_hi - p.ph_lo) > 1;
    XcdBarrier bar; bar.bar = (unsigned*)(ctl + CW_BAR); bar.x = 0; bar.st = nullptr;
    if (one) bar = xcd_barrier_post((unsigned*)(ctl + CW_BAR), MISC + 8);
    const int lo = p.ph_lo, hi = p.ph_hi;
#define IN(k) (lo <= (k) && (k) < hi)
#define SEAM(k) do { if (IN(k) && IN((k) + 1)) xcd_barrier(bar); } while (0)
    const int NGW = G * NWAVES;
#define PHASE_IDS const int tid = tid_opaque(), lane = tid & 63, wave = __builtin_amdgcn_readfirstlane(tid >> 6), gw = vcu * NWAVES + wave; (void)lane; (void)gw; (void)tid
    bf16_t* H = (bf16_t*)(p.ws + WS_H);

    if (IN(0)) for (int prep = 0; prep < 1 + ((PROBE_MASK >> 0) & 1); ++prep) { PHASE_IDS; if (prep) xcd_barrier(bar);
        convert_weights(p, (float*)(lds + wave * 16384), gw, NGW, lane);
        for (int row = gw; row < R; row += 2 * NGW) { const int row2 = row + NGW;
            if (row2 < R) rms_row2_to_bf16(xrow(p, row), xrow(p, row2), p.g_pre, H + (size_t)row * D, H + (size_t)row2 * D, lane);
            else rms_row_to_bf16(xrow(p, row), p.g_pre, H + (size_t)row * D, lane); }
    }
    SEAM(0);
    if (IN(1)) for (int prep = 0; prep < 1 + ((PROBE_MASK >> 1) & 1); ++prep) { PHASE_IDS; if (prep) xcd_barrier(bar);
        const EpiIn EI{(bf16_t*)(p.ws + WS_Q), (bf16_t*)(p.ws + WS_K), (bf16_t*)(p.ws + WS_V), (bf16_t*)(p.ws + WS_U), (bf16_t*)(p.ws + WS_SA), (bf16_t*)(p.ws + WS_SB), p.out, p.pscale};
        for (int u = bx; u < NMAIN / 32; u += G) { WgAcc acc = wg_zero();
            wg_skinny(acc, lds, H, D, MP + 32 * wave, (const bf16_t*)(p.ws + WS_WIN), D, 32 * u, 0, D, tid, lane);
            wave_epi32(acc, MP + 32 * wave, 32 * u, lane, EI); }
        __syncthreads();
        for (int ub = 2 * bx; ub < R / 32; ub += 2 * G) { const int blk = ub + (wave >> 2), ks = wave & 3; WgAcc acc = wg_zero();
            if (blk < R / 32) wave_gemm32(acc, H, D, 32 * blk, (const bf16_t*)(p.ws + WS_WIN) + (size_t)NMAIN * D, D, 0, 16, 512 * ks, 512, lane);
            float* red = (float*)lds;
            { const int fr = lane & 15, fq = lane >> 4;
#pragma unroll
              for (int tm = 0; tm < 2; ++tm) *(f32x4*)(red + (wave * 32 + 16 * tm + fr) * 16 + 4 * fq) = acc.t[tm][0]; }
            __syncthreads();
            if (tid < 256) { const int u2 = tid >> 7, rr = (tid >> 2) & 31, c4 = (tid & 3) * 4, blk2 = ub + u2;
                if (blk2 < R / 32) { f32x4 v = {0.f, 0.f, 0.f, 0.f};
#pragma unroll
                    for (int k4 = 0; k4 < 4; ++k4) v += *(const f32x4*)(red + ((u2 * 4 + k4) * 32 + rr) * 16 + c4);
                    EpiLogf EL{(float*)(p.ws + WS_LOGF), p.out, p.b_f}; EL(32 * blk2 + rr, c4, v); } }
            __syncthreads(); }
        pg8::Gemm g{H, (const bf16_t*)(p.ws + WS_WIN), MP, NMAIN, D, D, 0}; pg8::StaticOrder S; S.init(MP, NMAIN, G, bx); S.rot = 4 * (bx & 7);
        EpiElem8<EpiIn> E{EI};
        pg8::gemm_phase<EpiElem8<EpiIn>, pg8::StaticOrder, true, true>(ldsl + RING_OFF, g, S, E);
    }
    SEAM(1);
    if (IN(2)) for (int prep = 0; prep < 1 + ((PROBE_MASK >> 2) & 1); ++prep) { PHASE_IDS; if (prep) xcd_barrier(bar);
        float* csl = (float*)(lds + LDS_CSL); float* wtot = (float*)(lds + LDS_CSL + 8320);
        const float* LOGF = (const float*)(p.ws + WS_LOGF);
        const attn_body::StaticOrder S(G, bx);
        const int sorder = bx & 1;
        for (int pass = 0; pass < 2; ++pass) {
          if (pass == 1 - sorder) {
            __syncthreads();
            { const int bh = S.vcu >> 1, b = bh / NH, h = bh % NH;
              block_cumsum_lds<4>(csl, wtot, SEQ, [&](int pos) { return LOGF[((size_t)b * SEQ + pos) * NH + h]; }); }
            const attn_body::AttnTensors AT{(const attn_body::bf16*)(p.ws + WS_Q), (const attn_body::bf16*)(p.ws + WS_K), (const attn_body::bf16*)(p.ws + WS_V), (attn_body::bf16*)(p.ws + ((((PROBE_MASK >> 2) & 1) && prep == 0) ? WS_TM : WS_Q))};
            attn_body::attn_phase<attn_body::StaticOrder>((char*)lds + RING_OFF, AT, S, LDS_CSL);
          }
          if (pass == sorder) {
            { const int gwv = bx * NWAVES + wave;
              for (int it = gwv; it < (MP / 32) * 4; it += G * NWAVES) { const int g = it & 3, row0 = (it >> 2) * 32 + (lane >> 5) * 16, c0 = g * 256 + (lane & 31) * 8;
                  if (g == 0) pool_seg16<2>(p, row0, c0); else if (g == 1) pool_seg16<4>(p, row0, c0); else if (g == 2) pool_seg16<8>(p, row0, c0); else pool_seg16<16>(p, row0, c0); }
              const int gt = bx * (NWAVES * 64) + tid;
              for (int it = gt; it < MS * (PW / 8); it += G * NWAVES * 64) pool_chunk(p, MP + it / (PW / 8), it % (PW / 8)); }
            for (int bh = bx; bh < SB_ * NH; bh += G) { const int b = bh / NH, h = bh % NH;
                __syncthreads();
                block_cumsum_lds<5>(csl, wtot, NKEY, [&](int pos) { return pos < PAST ? p.clf[((size_t)b * PAST + pos) * NH + h] : LOGF[((size_t)MP + b * SN + (pos - PAST)) * NH + h]; });
                sample_attn(p, bh, csl, (float*)lds, (bf16_t*)(p.ws + ((((PROBE_MASK >> 2) & 1) && prep == 0) ? WS_TM : WS_Q))); }
          }
        }
    }
    SEAM(2);
    if (IN(3)) for (int prep = 0; prep < 1 + ((PROBE_MASK >> 3) & 1); ++prep) { PHASE_IDS; if (prep) xcd_barrier(bar);
        const EpiPool EP{(const bf16_t*)(p.ws + WS_SB), (bf16_t*)(p.ws + WS_TM)}; const EpiUp EU{(const bf16_t*)(p.ws + WS_SA), (bf16_t*)(p.ws + WS_TM), (bf16_t*)(p.ws + WS_TM)};
        for (int cb = bx; cb < D / 32; cb += G) { const int row0 = MP + 32 * wave, col0 = 32 * cb;
            WgAcc a1 = wg_zero(), a2 = wg_zero();
            wg_skinny(a1, lds, (const bf16_t*)(p.ws + WS_PO) + (cb >> 4) * 256, PW, row0, (const bf16_t*)(p.ws + WS_WPOOL), 256, col0, 0, 256, tid, lane);
            wg_skinny(a2, lds + 16384, (const bf16_t*)(p.ws + WS_Q), AW, row0, (const bf16_t*)(p.ws + WS_WUP), AW, col0, 0, AW, tid, lane);
            const int fr = lane & 15, fq = lane >> 4;
#pragma unroll
            for (int tm = 0; tm < 2; ++tm)
#pragma unroll
                for (int tn = 0; tn < 2; ++tn) { const size_t off = (size_t)(row0 + 16 * tm + fr) * D + col0 + 16 * tn + 4 * fq;
                    const f32x4 sb = ld_bf16x4(EP.SB + off), sa = ld_bf16x4(EU.SA + off);
                    st_bf16x4(EU.T + off, a2.t[tm][tn] * sa + a1.t[tm][tn] * sb); } }
        __syncthreads();
        { int kpool = 256; asm volatile("" : "+s"(kpool));
          pg8::Gemm g{(const bf16_t*)(p.ws + WS_PO), (const bf16_t*)(p.ws + WS_WPOOL), MP, D, kpool, PW, 256}; pg8::StaticOrder S; S.init(MP, D, G, bx);
          EpiElem8L<EpiPool> E{EP};
          pg8::gemm_phase<EpiElem8L<EpiPool>, pg8::StaticOrder, true, true>(ldsl + RING_OFF, g, S, E); }
        __syncthreads();
        for (int prep5 = ((PROBE_MASK >> 14) & 1); prep5 >= 0; --prep5)
        { if (prep5 == 0 && ((PROBE_MASK >> 14) & 1)) __syncthreads(); pg8::Gemm g{(const bf16_t*)(p.ws + WS_Q), (const bf16_t*)(p.ws + WS_WUP), MP, D, AW, AW, 0}; pg8::StaticOrder S; S.init(MP, D, G, bx);
          EpiElem8L<EpiUp> E{EpiUp{EU.SA, EU.T, prep5 ? (bf16_t*)(p.ws + WS_H) : EU.O}};
          pg8::gemm_phase<EpiElem8L<EpiUp>, pg8::StaticOrder, true, true>(ldsl + RING_OFF, g, S, E); }
    }
    SEAM(3);
    if (IN(4)) for (int prep = 0; prep < 1 + ((PROBE_MASK >> 4) & 1); ++prep) { PHASE_IDS; if (prep) xcd_barrier(bar);
        for (int wu = bx; wu < (D / 32) * 4; wu += G) { const int ks = wu & 3, cb = wu >> 2; WgAcc acc = wg_zero();
            wg_skinny(acc, lds, (const bf16_t*)(p.ws + WS_TM), D, MP + 32 * wave, (const bf16_t*)(p.ws + WS_WOUT), D, 32 * cb, 512 * ks, 512, tid, lane);
            wave_epi32(acc, 32 * wave, 32 * cb, lane, EpiF32{(float*)(p.ws + WS_SLAB) + (size_t)ks * MS * D, D}); }
        __syncthreads();
        pg8::Gemm g{(const bf16_t*)(p.ws + WS_TM), (const bf16_t*)(p.ws + WS_WOUT), MP, D, D, D, 0}; pg8::StaticOrder S; S.init(MP, D, G, bx);
        EpiElem8<EpiBf16> E{EpiBf16{(bf16_t*)(p.ws + WS_MO), D}};
        pg8::gemm_phase<EpiElem8<EpiBf16>, pg8::StaticOrder, true, true>(ldsl + RING_OFF, g, S, E);
    }
    SEAM(4);
    if (IN(5)) for (int prep = 0; prep < 1 + ((PROBE_MASK >> 5) & 1); ++prep) { PHASE_IDS; if (prep) xcd_barrier(bar);
        const bf16_t* MO = (const bf16_t*)(p.ws + WS_MO);
        struct RowIn { u32x2 m[8]; f32x4 x[8]; };
        auto load_row = [&](RowIn& in, int row) {
            const f32x4* xr = (const f32x4*)xrow(p, row) + lane;
#pragma unroll
            for (int j = 0; j < 8; ++j) in.x[j] = xr[64 * j];
            if (row < MP) { const u32x2* mr = (const u32x2*)(MO + (size_t)row * D) + lane;
#pragma unroll
                for (int j = 0; j < 8; ++j) in.m[j] = mr[64 * j]; } };
        auto finish_row = [&](RowIn& inr, int row) {
            const f32x4* g1 = (const f32x4*)p.g_post + lane; const f32x4* g2 = (const f32x4*)p.g_ffn_pre + lane;
            struct { f32x4 v[8]; f32x4* x; } in; in.x = inr.x;
            if (row < MP) {
#pragma unroll
                for (int j = 0; j < 8; ++j) { const u32x2 w = inr.m[j]; in.v[j] = (f32x4){bflo(w.x), bfhi(w.x), bflo(w.y), bfhi(w.y)}; } }
            else { const f32x4* sl = (const f32x4*)((const float*)(p.ws + WS_SLAB) + (size_t)(row - MP) * D) + lane;
#pragma unroll
                for (int j = 0; j < 8; ++j) in.v[j] = (sl[64 * j] + sl[64 * j + MS * D / 4]) + (sl[64 * j + 2 * (MS * D / 4)] + sl[64 * j + 3 * (MS * D / 4)]); }
            float s = 0.f;
#pragma unroll
            for (int j = 0; j < 8; ++j) s += (in.v[j].x * in.v[j].x + in.v[j].y * in.v[j].y) + (in.v[j].z * in.v[j].z + in.v[j].w * in.v[j].w);
            const float r1 = rsqrtf(wave_sum(s) * (1.f / D) + EPS); float s2 = 0.f;
            f32x4* orow = (f32x4*)(p.out + O_Y + (size_t)row * D) + lane;
#pragma unroll
            for (int j = 0; j < 8; ++j) { in.v[j] = in.x[j] + in.v[j] * r1 * g1[64 * j]; orow[64 * j] = in.v[j]; s2 += (in.v[j].x * in.v[j].x + in.v[j].y * in.v[j].y) + (in.v[j].z * in.v[j].z + in.v[j].w * in.v[j].w); }
            const float r2 = rsqrtf(wave_sum(s2) * (1.f / D) + EPS);
            u32x2* o8 = (u32x2*)(H + (size_t)row * D) + lane;
#pragma unroll
            for (int j = 0; j < 8; ++j) { const f32x4 gg = g2[64 * j]; u32x2 w; w.x = pk2(in.v[j].x * r2 * gg.x, in.v[j].y * r2 * gg.y); w.y = pk2(in.v[j].z * r2 * gg.z, in.v[j].w * r2 * gg.w); o8[64 * j] = w; } };
        RowIn A, B;
        if (gw < R) load_row(A, gw);
        for (int row = gw; row < R; row += 2 * NGW) {
            if (row + NGW < R) load_row(B, row + NGW);
            finish_row(A, row);
            if (row + 2 * NGW < R) load_row(A, row + 2 * NGW);
            if (row + NGW < R) finish_row(B, row + NGW);
        }
    }
    SEAM(5);
    if (IN(6)) for (int prep = 0; prep < 1 + ((PROBE_MASK >> 6) & 1); ++prep) { PHASE_IDS; if (prep) xcd_barrier(bar);
        const EpiRelu2 ER{(bf16_t*)(p.ws + WS_Z)};
        for (int prep6 = 0; prep6 < 1 + ((PROBE_MASK >> 15) & 1); ++prep6)
        for (int u = bx; u < FF / 32; u += G) { WgAcc acc = wg_zero();
            wg_skinny(acc, lds, H, D, MP + 32 * wave, (const bf16_t*)(p.ws + WS_WFF1), D, 32 * u, 0, D, tid, lane);
            wave_epi32(acc, MP + 32 * wave, 32 * u, lane, ER); }
        __syncthreads();
        pg8::Gemm g{H, (const bf16_t*)(p.ws + WS_WFF1), MP, FF, D, D, 0}; pg8::StaticOrder S; S.init(MP, FF, G, bx);
        EpiElem8<EpiRelu2, 1 + ((PROBE_MASK >> 16) & 1)> E{ER};
        pg8::gemm_phase<EpiElem8<EpiRelu2, 1 + ((PROBE_MASK >> 16) & 1)>, pg8::StaticOrder, true, true>(ldsl + RING_OFF, g, S, E);
    }
    SEAM(6);
    if (IN(7)) for (int prep = 0; prep < 1 + ((PROBE_MASK >> 7) & 1); ++prep) { PHASE_IDS; if (prep) xcd_barrier(bar);
        for (int wu = bx; wu < (D / 32) * 4; wu += G) { const int ks = wu & 3, cb = wu >> 2; WgAcc acc = wg_zero();
            wg_skinny(acc, lds, (const bf16_t*)(p.ws + WS_Z), FF, MP + 32 * wave, (const bf16_t*)(p.ws + WS_WFF2), FF, 32 * cb, 2048 * ks, 2048, tid, lane);
            wave_epi32(acc, 32 * wave, 32 * cb, lane, EpiF32{(float*)(p.ws + WS_SLAB) + (size_t)ks * MS * D, D}); }
        __syncthreads();
        pg8::Gemm g{(const bf16_t*)(p.ws + WS_Z), (const bf16_t*)(p.ws + WS_WFF2), MP, D, FF, FF, 0}; pg8::StaticOrder S; S.init(MP, D, G, bx);
        EpiElem8<EpiBf16> E{EpiBf16{(bf16_t*)(p.ws + WS_FO), D}};
        pg8::gemm_phase<EpiElem8<EpiBf16>, pg8::StaticOrder, true, true>(ldsl + RING_OFF, g, S, E);
    }
    SEAM(7);
    if (IN(8)) for (int prep = 0; prep < 1 + ((PROBE_MASK >> 8) & 1); ++prep) { PHASE_IDS; if (prep) xcd_barrier(bar);
        const bf16_t* FO = (const bf16_t*)(p.ws + WS_FO);
        struct RowIn8 { u32x2 m[8]; f32x4 x[8]; };
        auto load_row = [&](RowIn8& in, int row) {
            const f32x4* orow = (const f32x4*)(p.out + O_Y + (size_t)row * D) + lane;
#pragma unroll
            for (int j = 0; j < 8; ++j) in.x[j] = orow[64 * j];
            if (row < MP) { const u32x2* fr = (const u32x2*)(FO + (size_t)row * D) + lane;
#pragma unroll
                for (int j = 0; j < 8; ++j) in.m[j] = fr[64 * j]; } };
        auto finish_row = [&](RowIn8& inr, int row) {
            const f32x4* g3 = (const f32x4*)p.g_ffn_post + lane; float s = 0.f;
            struct { f32x4 v[8]; f32x4* x; } in; in.x = inr.x;
            if (row < MP) {
#pragma unroll
                for (int j = 0; j < 8; ++j) { const u32x2 w = inr.m[j]; in.v[j] = (f32x4){bflo(w.x), bfhi(w.x), bflo(w.y), bfhi(w.y)}; } }
            else { const f32x4* sl = (const f32x4*)((const float*)(p.ws + WS_SLAB) + (size_t)(row - MP) * D) + lane;
#pragma unroll
                for (int j = 0; j < 8; ++j) in.v[j] = (sl[64 * j] + sl[64 * j + MS * D / 4]) + (sl[64 * j + 2 * (MS * D / 4)] + sl[64 * j + 3 * (MS * D / 4)]); }
#pragma unroll
            for (int j = 0; j < 8; ++j) s += (in.v[j].x * in.v[j].x + in.v[j].y * in.v[j].y) + (in.v[j].z * in.v[j].z + in.v[j].w * in.v[j].w);
            const float r1 = rsqrtf(wave_sum(s) * (1.f / D) + EPS);
            f32x4* orow = (f32x4*)(p.out + O_Y + (size_t)row * D) + lane;
#pragma unroll
            for (int j = 0; j < 8; ++j) orow[64 * j] = in.x[j] + in.v[j] * r1 * g3[64 * j]; };
        RowIn8 A, B;
        if (gw < R) load_row(A, gw);
        for (int row = gw; row < R; row += 2 * NGW) {
            if (row + NGW < R) load_row(B, row + NGW);
            finish_row(A, row);
            if (row + 2 * NGW < R) load_row(A, row + 2 * NGW);
            if (row + NGW < R) finish_row(B, row + NGW);
        }
    }
#undef IN
#undef SEAM
#undef PHASE_IDS
}

#ifndef MK_SPLIT
#define MK_SPLIT 0
#endif
constexpr int NPHASE = 9;
extern "C" void kernel_launch(void* const* d_in, const int* in_sizes, int n_in, void* d_out, int out_size, void* d_ws, size_t ws_size, hipStream_t stream) {
    static int grid = 0;
    if (grid == 0) {
        if (n_in != 18 || (size_t)out_size != O_END || ws_size < WS_END) { fprintf(stderr, "kernel_launch: unexpected sizes n_in %d out %d ws %zu\n", n_in, out_size, ws_size); grid = -1; return; }
        int dev = 0, cus = 0, per_cu = 0;
        if (hipGetDevice(&dev) != hipSuccess || hipDeviceGetAttribute(&cus, hipDeviceAttributeMultiprocessorCount, dev) != hipSuccess) { grid = -1; return; }
        if (hipFuncSetAttribute((const void*)mega_fwd, hipFuncAttributeMaxDynamicSharedMemorySize, LDS_BYTES) != hipSuccess) { fprintf(stderr, "kernel_launch: hipFuncSetAttribute failed\n"); grid = -1; return; }
        if (hipOccupancyMaxActiveBlocksPerMultiprocessor(&per_cu, (const void*)mega_fwd, NWAVES * 64, LDS_BYTES) != hipSuccess || per_cu < 1) { fprintf(stderr, "kernel_launch: occupancy query says %d blocks per CU\n", per_cu); (void)hipGetLastError(); grid = -1; return; }
        grid = cus;
        if (grid > 256) grid = 256;
        grid &= ~7;
    }
    if (grid <= 0) return;
    (void)hipMemsetAsync((char*)d_ws + WS_CTL, 0, CTL_ZERO_BYTES, stream);
    Params p{};
    p.xp = (const float*)d_in[0]; p.xs = (const float*)d_in[1]; p.ck = (const float*)d_in[2]; p.cv = (const float*)d_in[3]; p.clf = (const float*)d_in[4]; p.sp = (const float*)d_in[5];
    p.g_pre = (const float*)d_in[6]; p.w_in = (const float*)d_in[7]; p.b_f = (const float*)d_in[8]; p.w_up = (const float*)d_in[9]; p.w_pool = (const float*)d_in[10]; p.pscale = (const float*)d_in[11];
    p.w_out = (const float*)d_in[12]; p.g_post = (const float*)d_in[13]; p.g_ffn_pre = (const float*)d_in[14]; p.w_ff1 = (const float*)d_in[15]; p.w_ff2 = (const float*)d_in[16]; p.g_ffn_post = (const float*)d_in[17];
    p.out = (float*)d_out; p.ws = (unsigned char*)d_ws;
#if MK_SPLIT
    for (int k = 0; k < NPHASE; ++k) { p.ph_lo = k; p.ph_hi = k + 1; hipLaunchKernelGGL(mega_fwd, dim3(grid), dim3(NWAVES * 64), LDS_BYTES, stream, p); }
#else
    p.ph_lo = 0; p.ph_hi = NPHASE;
    hipLaunchKernelGGL(mega_fwd, dim3(grid), dim3(NWAVES * 64), LDS_BYTES, stream, p);
#endif
}
```
